# Optimizing an MI355X kernel written in HIP

```python
import jax, jax.numpy as jnp
from jax import lax
import numpy as np

D_MODEL = 1024
BATCH = 16
SEQ = 4096
DEPTH = 4

HEAD_DIM = 64
GRID_W = 64
D_FOURIER = D_MODEL // 4
D_LRU = 3 * D_MODEL // 8
D_NA = D_MODEL - D_FOURIER - D_LRU
D_MIX = D_FOURIER + D_LRU + D_NA
N_FOURIER_GROUPS = D_FOURIER // HEAD_DIM
N_LRU_HEADS = D_LRU // HEAD_DIM
N_NA_HEADS = D_NA // HEAD_DIM
D_IN = D_FOURIER + 2 * D_LRU + 3 * D_NA
CONV_W = 4
CONV_PAD_LEFT = 2
CONV_PAD_RIGHT = CONV_W - 1 - CONV_PAD_LEFT
LRU_C = 8.0
NA_KH = 8
NA_KW = 16
D_FF = -(-(8 * D_MODEL) // (3 * 256)) * 256
N_MOD = 6
EPS = 1e-6

kernel_name = "hybrid_fnet_rglru_natten_encoder"


def rms_norm(x, g):
    xf = x.astype(jnp.float32)
    y = xf * lax.rsqrt(jnp.mean(xf * xf, axis=-1, keepdims=True) + EPS)
    return (y * g.astype(jnp.float32)).astype(x.dtype)


def modulate(h, shift, scale):
    return h * (1 + scale[:, None, :]) + shift[:, None, :]


def fourier_mix(u, w_map):
    B, S, _ = u.shape
    ug = u.astype(jnp.float32).reshape(B, S, N_FOURIER_GROUPS, HEAD_DIM)
    f = jnp.real(jnp.fft.fft2(ug, axes=(1, 3), norm="ortho")).astype(u.dtype)
    y = jnp.einsum('bsgd,gde->bsge', f, w_map)
    return y.reshape(B, S, D_FOURIER)


def centred_depthwise_conv(u, w, b):
    S = u.shape[1]
    up = jnp.pad(u, ((0, 0), (CONV_PAD_LEFT, CONV_PAD_RIGHT), (0, 0)))
    y = sum(w[k] * up[:, k:k + S, :] for k in range(CONV_W))
    return y + b


def _linear_recurrence_combine(left, right):
    a_l, b_l = left
    a_r, b_r = right
    return a_l * a_r, a_r * b_l + b_r


def rg_lru_direction(u, w_a, b_a, w_x, b_x, lam, reverse):
    B, S, _ = u.shape
    uh = u.reshape(B, S, N_LRU_HEADS, HEAD_DIM)
    ra = jnp.einsum('bshd,hde->bshe', uh, w_a).reshape(B, S, D_LRU) + b_a
    rx = jnp.einsum('bshd,hde->bshe', uh, w_x).reshape(B, S, D_LRU) + b_x
    r = jax.nn.sigmoid(ra.astype(jnp.float32))
    i = jax.nn.sigmoid(rx.astype(jnp.float32))
    log_a = -LRU_C * r * jax.nn.softplus(-lam.astype(jnp.float32))
    a = jnp.exp(log_a)
    bterm = jnp.sqrt(-jnp.expm1(2.0 * log_a)) * (i * u.astype(jnp.float32))
    _, h = lax.associative_scan(_linear_recurrence_combine, (a, bterm), axis=1, reverse=reverse)
    return h


def neighbourhood_attention(q, k, v, rpb):
    B, S, H, dh = q.shape
    rows = S // GRID_W
    kh = min(NA_KH, rows)
    kw = NA_KW
    qg = q.reshape(B, rows, GRID_W, H, dh) * (HEAD_DIM ** -0.5)
    kg = k.reshape(B, rows, GRID_W, H, dh)
    vg = v.reshape(B, rows, GRID_W, H, dh)
    row_start = jnp.clip(jnp.arange(rows) - kh // 2, 0, rows - kh)
    cols = jnp.arange(GRID_W)
    col_start = jnp.clip(cols - kw // 2, 0, GRID_W - kw)
    col_idx = col_start[:, None] + jnp.arange(kw)[None, :]
    dc = col_idx - cols[:, None] + (NA_KW - 1)
    bias_c = rpb[:, :, dc]

    def one_row(r):
        rs = row_start[r]
        k_band = lax.dynamic_slice_in_dim(kg, rs, kh, axis=1)
        v_band = lax.dynamic_slice_in_dim(vg, rs, kh, axis=1)
        k_win = k_band[:, :, col_idx]
        v_win = v_band[:, :, col_idx]
        q_row = lax.dynamic_index_in_dim(qg, r, axis=1, keepdims=False)
        s = jnp.einsum('bqhd,brqkhd->bhqrk', q_row, k_win)
        dr = rs + jnp.arange(kh) - r + (NA_KH - 1)
        bias = jnp.transpose(bias_c[:, dr], (0, 2, 1, 3))
        s = s.astype(jnp.float32) + bias.astype(jnp.float32)
        p = jax.nn.softmax(s.reshape(B, H, GRID_W, kh * kw), axis=-1)
        p = p.reshape(B, H, GRID_W, kh, kw).astype(v.dtype)
        return jnp.einsum('bhqrk,brqkhd->bqhd', p, v_win)

    out = lax.map(one_row, jnp.arange(rows, dtype=jnp.int32))
    return jnp.transpose(out, (1, 0, 2, 3, 4)).reshape(B, S, H * dh)


def setup_inputs(seed: int = 0) -> dict:
    key = jax.random.key(seed)
    ks = jax.random.split(key, 24)
    f32 = jnp.float32

    def nrm(k, shape, scale):
        return jax.random.normal(k, shape, f32) * scale

    u = jax.random.uniform(ks[12], (DEPTH, 2, D_LRU), f32, minval=0.9, maxval=0.999)
    s = u ** (1.0 / LRU_C)
    lam = jnp.log(s) - jnp.log1p(-s)
    return {
        "x": nrm(ks[0], (BATCH, SEQ, D_MODEL), 1.0),
        "c": nrm(ks[1], (BATCH, D_MODEL), 1.0),
        "w_ada": nrm(ks[2], (DEPTH, D_MODEL, N_MOD * D_MODEL), 0.5 * D_MODEL ** -0.5),
        "b_ada": nrm(ks[3], (DEPTH, N_MOD * D_MODEL), 0.02),
        "g_mix": 1.0 + nrm(ks[4], (DEPTH, D_MODEL), 0.02),
        "g_ffn": 1.0 + nrm(ks[5], (DEPTH, D_MODEL), 0.02),
        "w_in": nrm(ks[6], (DEPTH, D_MODEL, D_IN), D_MODEL ** -0.5),
        "w_fourier": nrm(ks[7], (DEPTH, N_FOURIER_GROUPS, HEAD_DIM, HEAD_DIM), HEAD_DIM ** -0.5),
        "conv_w": nrm(ks[8], (DEPTH, CONV_W, D_LRU), 0.5),
        "conv_b": nrm(ks[9], (DEPTH, D_LRU), 0.02),
        "lru_w_a": nrm(ks[10], (DEPTH, 2, N_LRU_HEADS, HEAD_DIM, HEAD_DIM), HEAD_DIM ** -0.5),
        "lru_b_a": nrm(ks[11], (DEPTH, 2, D_LRU), 0.02),
        "lru_w_x": nrm(ks[13], (DEPTH, 2, N_LRU_HEADS, HEAD_DIM, HEAD_DIM), HEAD_DIM ** -0.5),
        "lru_b_x": nrm(ks[14], (DEPTH, 2, D_LRU), 0.02),
        "lru_lambda": lam,
        "na_rpb": nrm(ks[15], (DEPTH, N_NA_HEADS, 2 * NA_KH - 1, 2 * NA_KW - 1), 0.1),
        "w_out": nrm(ks[16], (DEPTH, D_MIX, D_MODEL), D_MIX ** -0.5),
        "w_ffn_gate": nrm(ks[17], (DEPTH, D_MODEL, D_FF), D_MODEL ** -0.5),
        "w_ffn_up": nrm(ks[18], (DEPTH, D_MODEL, D_FF), D_MODEL ** -0.5),
        "w_ffn_down": nrm(ks[19], (DEPTH, D_FF, D_MODEL), D_FF ** -0.5),
        "g_final": 1.0 + nrm(ks[20], (D_MODEL,), 0.02),
    }


def reference(x, c, w_ada, b_ada, g_mix, g_ffn, w_in, w_fourier, conv_w, conv_b,
              lru_w_a, lru_b_a, lru_w_x, lru_b_x, lru_lambda, na_rpb, w_out,
              w_ffn_gate, w_ffn_up, w_ffn_down, g_final):
    B, S, _ = x.shape
    c_act = jax.nn.silu(c)
    o1 = D_FOURIER
    o2 = o1 + D_LRU
    o3 = o2 + D_LRU
    o4 = o3 + D_NA
    o5 = o4 + D_NA
    for l in range(DEPTH):
        mod = c_act @ w_ada[l] + b_ada[l]
        sh1, sc1, gt1, sh2, sc2, gt2 = jnp.split(mod, N_MOD, axis=-1)

        h = modulate(rms_norm(x, g_mix[l]), sh1, sc1)
        p = h @ w_in[l]
        p_f, p_x, p_g = p[..., :o1], p[..., o1:o2], p[..., o2:o3]
        q = p[..., o3:o4].reshape(B, S, N_NA_HEADS, HEAD_DIM)
        k = p[..., o4:o5].reshape(B, S, N_NA_HEADS, HEAD_DIM)
        v = p[..., o5:].reshape(B, S, N_NA_HEADS, HEAD_DIM)

        y_f = fourier_mix(p_f, w_fourier[l])

        u = centred_depthwise_conv(p_x, conv_w[l], conv_b[l])
        h_fwd = rg_lru_direction(u, lru_w_a[l, 0], lru_b_a[l, 0], lru_w_x[l, 0],
                                 lru_b_x[l, 0], lru_lambda[l, 0], reverse=False)
        h_bwd = rg_lru_direction(u, lru_w_a[l, 1], lru_b_a[l, 1], lru_w_x[l, 1],
                                 lru_b_x[l, 1], lru_lambda[l, 1], reverse=True)
        y_l = jax.nn.gelu(p_g) * (h_fwd + h_bwd).astype(p_g.dtype)

        y_n = neighbourhood_attention(q, k, v, na_rpb[l])

        y = jnp.concatenate([y_f, y_l, y_n], axis=-1) @ w_out[l]
        x = x + gt1[:, None, :] * y

        h = modulate(rms_norm(x, g_ffn[l]), sh2, sc2)
        f = (jax.nn.silu(h @ w_ffn_gate[l]) * (h @ w_ffn_up[l])) @ w_ffn_down[l]
        x = x + gt2[:, None, :] * f
    return rms_norm(x, g_final)
```

```cpp
#include <hip/hip_runtime.h>
#include <hip/hip_cooperative_groups.h>
#include <cstdio>
#include <cstdint>
namespace cg = cooperative_groups;
namespace pg8 {
#define PG8_LAS __attribute__((address_space(3)))
typedef unsigned short bf16_t;
typedef short bf16x8 __attribute__((ext_vector_type(8)));
typedef float f32x4 __attribute__((ext_vector_type(4)));
typedef unsigned u32x4 __attribute__((ext_vector_type(4)));
typedef unsigned u32x2 __attribute__((ext_vector_type(2)));
constexpr int BM = 256, BK = 64, HALF = 128, HTB = HALF * BK * 2  , STAGE_BYTES = 8 * HTB, NXCD = 8, WGM = 8;

__host__ __device__ __forceinline__ int lds_byte(int r, int c) { const int st = (r >> 4) * 2 + (c >> 5), rr = r & 15, cc = c & 31, ob = rr * 64 + cc * 2; return st * 1024 + (ob ^ (((ob >> 9) & 1) << 5)); }
__host__ __device__ __forceinline__ void stage_rc(int b, int& R, int& C) { const int st = b / 1024, sb = b % 1024, swz = sb ^ (((sb >> 9) & 1) << 5); R = (st >> 1) * 16 + swz / 64; C = (st & 1) * 32 + (swz % 64) / 2; }
__host__ __device__ __forceinline__ int perm32(int rho) { const int n = rho >> 4, i = rho & 15; return 8 * (i >> 2) + 4 * n + (i & 3); }

struct Unit { int pm, pn; };
struct Gemm { const bf16_t* A; const bf16_t* Bt; int M, N, K; };

struct StaticOrder {
    int nM, nN, nwg, G, c;
    __host__ __device__ void init(int M, int N, int G_, int c_) { nM = M / BM; nN = N / BM; nwg = nM * nN; G = G_; c = c_; }
    __host__ __device__ bool next(int i, Unit& u) const {
        const long L = (long)i * G + c; if (L >= nwg) return false;
        int wgid = (int)L; { const int q = nwg / NXCD, r = nwg % NXCD, xcd = wgid % NXCD, off = wgid / NXCD; wgid = (xcd < r ? xcd * (q + 1) : r * (q + 1) + (xcd - r) * q) + off; }
        const int nig = WGM * nN, gid = wgid / nig, fm = gid * WGM, gsz = (nM - fm) < WGM ? (nM - fm) : WGM;
        u.pm = fm + ((wgid % nig) % gsz); u.pn = (wgid % nig) / gsz; return true;
    }
    __device__ __forceinline__ void a_ready(const Unit&) const {}
    __device__ __forceinline__ void done(const Unit&) const {}
};

typedef float cvt_f32x2 __attribute__((ext_vector_type(2)));
typedef __bf16 cvt_bf16x2 __attribute__((ext_vector_type(2)));
__device__ __forceinline__ unsigned cvt_pk_bf16(float lo, float hi) { const cvt_f32x2 v = {lo, hi}; const cvt_bf16x2 b = __builtin_convertvector(v, cvt_bf16x2); return __builtin_bit_cast(unsigned, b); }

#ifdef DBG_FLAGS
#define PG_CHK(dbgp, v, bit) do {} while (0)
#else
#define PG_CHK(dbgp, v, bit) do {} while (0)
#endif
__device__ __forceinline__ float row_rstd(const float* SS, int row, int fq) {
    const f32x4 v = *(const f32x4*)(SS + (size_t)row * 16 + 4 * fq);
    float s = (v[0] + v[1]) + (v[2] + v[3]);
    s += __shfl_xor(s, 16); s += __shfl_xor(s, 32);
    return rsqrtf(s * (1.0f / 1024.0f) + 1e-6f);
}
struct EpiP {
    static constexpr bool PERM = true, AFTER_DRAIN = false;
    bf16_t* O; int ldc; const float* SS; const float* bias; int bias_ld;
    __device__ __forceinline__ void operator()(const f32x4 (&acc)[2][2][4][2], const Unit& u, int wr, int wc, int fr, int fq) const {
        const int row0 = u.pm * BM + wr * 64 + fr, col0 = u.pn * BM + wc * 32 + 8 * fq;
        const float* bp = bias + (size_t)(u.pm >> 4) * bias_ld + col0;
        f32x4 bv[2][2];
#pragma unroll
        for (int bj = 0; bj < 2; ++bj)
#pragma unroll
            for (int n = 0; n < 2; ++n) bv[bj][n] = *(const f32x4*)(bp + bj * HALF + 4 * n);
        float rsv[2][4];
        { f32x4 sv[2][4];
#pragma unroll
          for (int ai = 0; ai < 2; ++ai)
#pragma unroll
              for (int m = 0; m < 4; ++m) sv[ai][m] = *(const f32x4*)(SS + (size_t)(row0 + ai * HALF + m * 16) * 16 + 4 * fq);
          __builtin_amdgcn_sched_barrier(0);
#pragma unroll
          for (int ai = 0; ai < 2; ++ai)
#pragma unroll
              for (int m = 0; m < 4; ++m) { float t = (sv[ai][m][0] + sv[ai][m][1]) + (sv[ai][m][2] + sv[ai][m][3]); t += __shfl_xor(t, 16); t += __shfl_xor(t, 32); rsv[ai][m] = rsqrtf(t * (1.0f / 1024.0f) + 1e-6f); } }
#pragma unroll
        for (int ai = 0; ai < 2; ++ai)
#pragma unroll
            for (int m = 0; m < 4; ++m) { const int row = row0 + ai * HALF + m * 16; const float rs = rsv[ai][m];
                bf16_t* rowp = O + (size_t)row * ldc + col0;
#pragma unroll
                for (int bj = 0; bj < 2; ++bj) { const f32x4 v0 = acc[ai][bj][m][0] * rs + bv[bj][0], v1 = acc[ai][bj][m][1] * rs + bv[bj][1];
                    u32x4 w; w.x = cvt_pk_bf16(v0[0], v0[1]); w.y = cvt_pk_bf16(v0[2], v0[3]); w.z = cvt_pk_bf16(v1[0], v1[1]); w.w = cvt_pk_bf16(v1[2], v1[3]);
                    *(u32x4*)(rowp + bj * HALF) = w; } }
    }
};
struct EpiRes {
    static constexpr bool PERM = true, AFTER_DRAIN = false;
    const float* xin32; const bf16_t* xin16; bf16_t* xout; const float* gate; const float* gmul; const float* gsc; bf16_t* Hn; float* SS;
    __device__ __forceinline__ void operator()(const f32x4 (&acc)[2][2][4][2], const Unit& u, int wr, int wc, int fr, int fq) const {
        const int row0 = u.pm * BM + wr * 64 + fr, col0 = u.pn * BM + wc * 32 + 8 * fq;
        const float* gp = gate + (size_t)(u.pm >> 4) * 6144 + col0;
        const float* sp_ = gsc + (size_t)(u.pm >> 4) * 6144 + col0;
        const bool emit = gmul != nullptr, in16 = xin16 != nullptr;
        f32x4 gv[2][2], gm[2][2];
#pragma unroll
        for (int bj = 0; bj < 2; ++bj)
#pragma unroll
            for (int n = 0; n < 2; ++n) { const int co = bj * HALF + 4 * n; gv[bj][n] = *(const f32x4*)(gp + co);
                gm[bj][n] = emit ? *(const f32x4*)(gmul + col0 + co) * (*(const f32x4*)(sp_ + co) + 1.0f) : (f32x4){0.f, 0.f, 0.f, 0.f}; }
        u32x4 xb[2][2];
        if (in16) {
#pragma unroll
            for (int bj = 0; bj < 2; ++bj) xb[0][bj] = *(const u32x4*)(xin16 + (size_t)row0 * 1024 + col0 + bj * HALF); }
#pragma unroll
        for (int it = 0; it < 8; ++it) { const int ai = it >> 2, m = it & 3, row = row0 + ai * HALF + m * 16; const size_t off = (size_t)row * 1024 + col0;
            f32x4 xf[2][2];
            if (in16) {
                if (it < 7) { const size_t offn = (size_t)(row0 + ((it + 1) >> 2) * HALF + ((it + 1) & 3) * 16) * 1024 + col0;
#pragma unroll
                    for (int bj = 0; bj < 2; ++bj) xb[(it + 1) & 1][bj] = *(const u32x4*)(xin16 + offn + bj * HALF); }
#pragma unroll
                for (int bj = 0; bj < 2; ++bj) { const u32x4 w = xb[it & 1][bj];
                    xf[bj][0] = (f32x4){__builtin_bit_cast(float, w.x << 16), __builtin_bit_cast(float, w.x & 0xffff0000u), __builtin_bit_cast(float, w.y << 16), __builtin_bit_cast(float, w.y & 0xffff0000u)};
                    xf[bj][1] = (f32x4){__builtin_bit_cast(float, w.z << 16), __builtin_bit_cast(float, w.z & 0xffff0000u), __builtin_bit_cast(float, w.w << 16), __builtin_bit_cast(float, w.w & 0xffff0000u)}; }
            } else {
#pragma unroll
                for (int bj = 0; bj < 2; ++bj)
#pragma unroll
                    for (int n = 0; n < 2; ++n) xf[bj][n] = *(const f32x4*)(xin32 + off + bj * HALF + 4 * n);
            }
            float ss = 0.f;
#pragma unroll
            for (int bj = 0; bj < 2; ++bj) { const f32x4 x0 = xf[bj][0] + gv[bj][0] * acc[ai][bj][m][0], x1 = xf[bj][1] + gv[bj][1] * acc[ai][bj][m][1];
                u32x4 w; w.x = cvt_pk_bf16(x0[0], x0[1]); w.y = cvt_pk_bf16(x0[2], x0[3]); w.z = cvt_pk_bf16(x1[0], x1[1]); w.w = cvt_pk_bf16(x1[2], x1[3]);
                *(u32x4*)(xout + off + bj * HALF) = w;
                if (emit) { const f32x4 h0 = x0 * gm[bj][0], h1 = x1 * gm[bj][1];
                    ss += ((x0[0] * x0[0] + x0[1] * x0[1]) + (x0[2] * x0[2] + x0[3] * x0[3])) + ((x1[0] * x1[0] + x1[1] * x1[1]) + (x1[2] * x1[2] + x1[3] * x1[3]));
                    u32x4 hw; hw.x = cvt_pk_bf16(h0[0], h0[1]); hw.y = cvt_pk_bf16(h0[2], h0[3]); hw.z = cvt_pk_bf16(h1[0], h1[1]); hw.w = cvt_pk_bf16(h1[2], h1[3]);
                    *(u32x4*)(Hn + off + bj * HALF) = hw; } }
            if (emit) { ss += __shfl_xor(ss, 16); ss += __shfl_xor(ss, 32); if (fq == 0) SS[(size_t)row * 16 + u.pn * 4 + wc] = ss; }
            __builtin_amdgcn_sched_barrier(0); }
    }
};
struct EpiSwiGLU {
    static constexpr bool PERM = true, AFTER_DRAIN = false;
    bf16_t* O; const float* SS; const float* bias;
    __device__ __forceinline__ void operator()(const f32x4 (&acc)[2][2][4][2], const Unit& u, int wr, int wc, int fr, int fq) const {
        const int row0 = u.pm * BM + wr * 64 + fr, col0 = u.pn * HALF + wc * 32 + 8 * fq;
        const float* bp = bias + (size_t)(u.pm >> 4) * 5632 + u.pn * BM + wc * 32 + 8 * fq;
        f32x4 bv[2][2];
#pragma unroll
        for (int bj = 0; bj < 2; ++bj)
#pragma unroll
            for (int n = 0; n < 2; ++n) bv[bj][n] = *(const f32x4*)(bp + bj * HALF + 4 * n);
        float rsv[2][4];
        { f32x4 sv[2][4];
#pragma unroll
          for (int ai = 0; ai < 2; ++ai)
#pragma unroll
              for (int m = 0; m < 4; ++m) sv[ai][m] = *(const f32x4*)(SS + (size_t)(row0 + ai * HALF + m * 16) * 16 + 4 * fq);
          __builtin_amdgcn_sched_barrier(0);
#pragma unroll
          for (int ai = 0; ai < 2; ++ai)
#pragma unroll
              for (int m = 0; m < 4; ++m) { float t = (sv[ai][m][0] + sv[ai][m][1]) + (sv[ai][m][2] + sv[ai][m][3]); t += __shfl_xor(t, 16); t += __shfl_xor(t, 32); rsv[ai][m] = rsqrtf(t * (1.0f / 1024.0f) + 1e-6f); } }
#pragma unroll
        for (int ai = 0; ai < 2; ++ai)
#pragma unroll
            for (int m = 0; m < 4; ++m) { const int row = row0 + ai * HALF + m * 16; const float rs = rsv[ai][m];
                bf16_t* rowp = O + (size_t)row * 2816 + col0;
                float r[8];
#pragma unroll
                for (int n = 0; n < 2; ++n)
#pragma unroll
                    for (int j = 0; j < 4; ++j) { const float g = acc[ai][0][m][n][j] * rs + bv[0][n][j], up = acc[ai][1][m][n][j] * rs + bv[1][n][j];
                        r[4 * n + j] = g * __builtin_amdgcn_rcpf(1.0f + __expf(-g)) * up; }
                u32x4 w; w.x = cvt_pk_bf16(r[0], r[1]); w.y = cvt_pk_bf16(r[2], r[3]); w.z = cvt_pk_bf16(r[4], r[5]); w.w = cvt_pk_bf16(r[6], r[7]);
                *(u32x4*)rowp = w; }
    }
};
template <class Epi, class Sched, bool ALIGN_EPI = false, bool SP2 = false>
__device__ __forceinline__ void gemm_phase(PG8_LAS unsigned char* lds, const Gemm g, const Sched& S, const Epi& E) {
    int tid_ = threadIdx.x; asm volatile("" : "+v"(tid_));
    const int tid = tid_, wid = __builtin_amdgcn_readfirstlane(tid >> 6), lane = tid & 63, wr = wid >> 2, wc = wid & 3, fr = lane & 15, fq = lane >> 4;
    const int K = g.K, nt = K / BK;
    unsigned voffA[2], voffB[2];
#pragma unroll
    for (int i = 0; i < 2; ++i) { int R, C; stage_rc(tid * 16 + i * 8192, R, C); const int Rb = Epi::PERM ? ((R & ~31) + perm32(R & 31)) : R;
        voffA[i] = (unsigned)(R * K + C) * 2u; voffB[i] = (unsigned)(Rb * K + C) * 2u; }
    const size_t kstep = (size_t)(BK * 2);
    const size_t hstep = (size_t)HALF * K * 2;
    const size_t tstep = 2 * hstep;
    const unsigned ldsw = (unsigned)wid * 1024u;
    const int aoff = lds_byte(wr * 64 + fr, fq * 8), boff = lds_byte(wc * 32 + fr, fq * 8);
#define PG8_SA(b, h) (((b) * 2 + (h)) * HTB)
#define PG8_SB(b, h) ((4 + (b) * 2 + (h)) * HTB)
#define PG8_STAGE(bufoff, gbase, voff) do { _Pragma("unroll") for (int _i = 0; _i < 2; ++_i) \
        __builtin_amdgcn_global_load_lds((const unsigned*)((const char*)(gbase) + (voff)[_i]), (PG8_LAS unsigned*)(lds + (bufoff) + ldsw + _i * 8192), 16, 0, 0); } while (0)
#define PG8_LDA(dst, b, h) do { _Pragma("unroll") for (int m = 0; m < 4; ++m) _Pragma("unroll") for (int k = 0; k < 2; ++k) dst[m][k] = *(const PG8_LAS bf16x8*)(lds + PG8_SA(b, h) + aoff + m * 2048 + k * 1024); } while (0)
#define PG8_LDB(dst, b, h) do { _Pragma("unroll") for (int n = 0; n < 2; ++n) _Pragma("unroll") for (int k = 0; k < 2; ++k) dst[n][k] = *(const PG8_LAS bf16x8*)(lds + PG8_SB(b, h) + boff + n * 2048 + k * 1024); } while (0)
#define PG8_MMA(ai, bj, At, Bt) do { __builtin_amdgcn_s_setprio(1); _Pragma("unroll") for (int m = 0; m < 4; ++m) _Pragma("unroll") for (int n = 0; n < 2; ++n) _Pragma("unroll") for (int k = 0; k < 2; ++k) \
        acc[ai][bj][m][n] = __builtin_amdgcn_mfma_f32_16x16x32_bf16(Bt[n][k], At[m][k], acc[ai][bj][m][n], 0, 0, 0); __builtin_amdgcn_s_setprio(0); } while (0)
#define PG8_WAIT_V(n) asm volatile("s_waitcnt vmcnt(" #n ")" ::: "memory")
#define PG8_WAIT_L(n) asm volatile("s_waitcnt lgkmcnt(" #n ")" ::: "memory")
#define PG8_BAR __builtin_amdgcn_s_barrier()
#define PG8_SCHED __builtin_amdgcn_sched_barrier(0)
    Unit cur, nxt; int ui = 0;
    if (!S.next(0, cur)) return;
    f32x4 acc[2][2][4][2];
#pragma unroll
    for (int a = 0; a < 2; ++a)
#pragma unroll
        for (int b = 0; b < 2; ++b)
#pragma unroll
            for (int m = 0; m < 4; ++m)
#pragma unroll
                for (int n = 0; n < 2; ++n) acc[a][b][m][n] = (f32x4){0.f, 0.f, 0.f, 0.f};
    bf16x8 At[4][2], B0[2][2], B1[2][2];
    const char* cA = (const char*)g.A + (size_t)cur.pm * tstep; const char* cB = (const char*)g.Bt + (size_t)cur.pn * tstep;
    S.a_ready(cur);
    if constexpr (SP2) {
        PG8_STAGE(PG8_SB(0, 0), cB, voffB); PG8_STAGE(PG8_SB(0, 1), cB + hstep, voffB); PG8_STAGE(PG8_SA(0, 0), cA, voffA); PG8_STAGE(PG8_SA(0, 1), cA + hstep, voffA);
        if (wr == 1) PG8_BAR;
        PG8_WAIT_V(2); PG8_BAR;
        PG8_STAGE(PG8_SB(1, 0), cB + kstep, voffB); PG8_STAGE(PG8_SA(1, 0), cA + kstep, voffA); PG8_STAGE(PG8_SB(1, 1), cB + hstep + kstep, voffB);
        PG8_WAIT_V(6); PG8_BAR;
    } else {
        PG8_STAGE(PG8_SB(0, 0), cB, voffB); PG8_STAGE(PG8_SA(0, 0), cA, voffA); PG8_STAGE(PG8_SB(0, 1), cB + hstep, voffB); PG8_STAGE(PG8_SA(0, 1), cA + hstep, voffA);
        if (wr == 1) PG8_BAR;
        PG8_WAIT_V(4); PG8_BAR;
        PG8_STAGE(PG8_SB(1, 0), cB + kstep, voffB); PG8_STAGE(PG8_SA(1, 0), cA + kstep, voffA); PG8_STAGE(PG8_SB(1, 1), cB + hstep + kstep, voffB);
        PG8_WAIT_V(6); PG8_BAR;
    }
    for (;;) {
        const bool has_next = S.next(ui + 1, nxt);
        const char* nA = has_next ? (const char*)g.A + (size_t)nxt.pm * tstep : cA; const char* nB = has_next ? (const char*)g.Bt + (size_t)nxt.pn * tstep : cB;
        for (int t = 0; t < nt; t += 2) {
            const bool last = (t == nt - 2);
            const char* a1 = cA + (size_t)(t + 1) * kstep;
            const char* a2 = last ? nA : cA + (size_t)(t + 2) * kstep; const char* b2 = last ? nB : cB + (size_t)(t + 2) * kstep;
            const char* a3 = a2 + kstep; const char* b3 = b2 + kstep;
            if (last && has_next) S.a_ready(nxt);
            if constexpr (SP2) {
            PG8_LDB(B0, 0, 0); PG8_LDB(B1, 0, 1); PG8_SCHED; PG8_LDA(At, 0, 0); PG8_STAGE(PG8_SA(1, 1), a1 + hstep, voffA);
            PG8_WAIT_V(8); PG8_WAIT_L(0); PG8_BAR; PG8_MMA(0, 0, At, B0); PG8_MMA(0, 1, At, B1); PG8_BAR; PG8_SCHED;
            PG8_LDA(At, 0, 1); PG8_STAGE(PG8_SB(0, 0), b2, voffB); PG8_STAGE(PG8_SB(0, 1), b2 + hstep, voffB); PG8_STAGE(PG8_SA(0, 0), a2, voffA);
            PG8_WAIT_V(8); PG8_WAIT_L(0); PG8_BAR; PG8_MMA(1, 0, At, B0); PG8_MMA(1, 1, At, B1); PG8_BAR; PG8_SCHED;
            PG8_LDB(B0, 1, 0); PG8_LDB(B1, 1, 1); PG8_SCHED; PG8_LDA(At, 1, 0); PG8_STAGE(PG8_SA(0, 1), a2 + hstep, voffA);
            PG8_WAIT_V(8); PG8_WAIT_L(0); PG8_BAR; PG8_MMA(0, 0, At, B0); PG8_MMA(0, 1, At, B1); PG8_BAR; PG8_SCHED;
            PG8_LDA(At, 1, 1); PG8_STAGE(PG8_SB(1, 0), b3, voffB); PG8_STAGE(PG8_SB(1, 1), b3 + hstep, voffB); PG8_STAGE(PG8_SA(1, 0), a3, voffA);
            PG8_WAIT_V(8); PG8_WAIT_L(0); PG8_BAR; PG8_MMA(1, 0, At, B0); PG8_MMA(1, 1, At, B1); PG8_BAR; PG8_SCHED;
            } else {
            PG8_LDB(B0, 0, 0); PG8_SCHED; PG8_LDA(At, 0, 0); PG8_STAGE(PG8_SA(1, 1), a1 + hstep, voffA);
            PG8_WAIT_L(8); PG8_BAR; PG8_WAIT_L(0); PG8_MMA(0, 0, At, B0); PG8_BAR; PG8_SCHED;
            PG8_LDB(B1, 0, 1); PG8_STAGE(PG8_SB(0, 0), b2, voffB);
            PG8_BAR; PG8_WAIT_L(0); PG8_MMA(0, 1, At, B1); PG8_BAR;
            PG8_LDA(At, 0, 1); PG8_STAGE(PG8_SA(0, 0), a2, voffA);
            PG8_BAR; PG8_WAIT_L(0); PG8_MMA(1, 0, At, B0); PG8_BAR; PG8_SCHED;
            PG8_STAGE(PG8_SB(0, 1), b2 + hstep, voffB);
            PG8_WAIT_V(6); PG8_BAR; PG8_MMA(1, 1, At, B1); PG8_BAR;
            PG8_LDB(B0, 1, 0); PG8_SCHED; PG8_LDA(At, 1, 0); PG8_STAGE(PG8_SA(0, 1), a2 + hstep, voffA);
            PG8_WAIT_L(8); PG8_BAR; PG8_WAIT_L(0); PG8_MMA(0, 0, At, B0); PG8_BAR; PG8_SCHED;
            PG8_LDB(B1, 1, 1); PG8_STAGE(PG8_SB(1, 0), b3, voffB);
            PG8_BAR; PG8_WAIT_L(0); PG8_MMA(0, 1, At, B1); PG8_BAR;
            PG8_LDA(At, 1, 1); PG8_STAGE(PG8_SA(1, 0), a3, voffA);
            PG8_BAR; PG8_WAIT_L(0); PG8_MMA(1, 0, At, B0); PG8_BAR; PG8_SCHED;
            PG8_STAGE(PG8_SB(1, 1), b3 + hstep, voffB);
            PG8_WAIT_V(6); PG8_BAR; PG8_MMA(1, 1, At, B1); PG8_BAR;
            }
        }
        if constexpr (ALIGN_EPI) { if (wr == 0) PG8_BAR; }
        if constexpr (!Epi::AFTER_DRAIN) { E(acc, cur, wr, wc, fr, fq); S.done(cur); }
        if (!has_next) break;
#pragma unroll
        for (int a = 0; a < 2; ++a)
#pragma unroll
            for (int b = 0; b < 2; ++b)
#pragma unroll
                for (int m = 0; m < 4; ++m)
#pragma unroll
                    for (int n = 0; n < 2; ++n) acc[a][b][m][n] = (f32x4){0.f, 0.f, 0.f, 0.f};
        cur = nxt; cA = nA; cB = nB; ++ui;
        if constexpr (ALIGN_EPI) { if (wr == 1) PG8_BAR; }
    }
    PG8_WAIT_V(0);
    if constexpr (!ALIGN_EPI) { if (wr == 0) PG8_BAR; }
    PG8_BAR;
    if constexpr (Epi::AFTER_DRAIN) { E.fused(acc, cur, wr, wc, fr, fq, lds, wid, lane); S.done(cur); }
#undef PG8_SA
#undef PG8_SB
#undef PG8_STAGE
#undef PG8_LDA
#undef PG8_LDB
#undef PG8_MMA
#undef PG8_WAIT_V
#undef PG8_WAIT_L
#undef PG8_BAR
#undef PG8_SCHED
}
}


#define LAS __attribute__((address_space(3)))
typedef unsigned short bf16;
typedef float f32x4 __attribute__((ext_vector_type(4)));
typedef short bf16x8 __attribute__((ext_vector_type(8)));
typedef unsigned u32x4 __attribute__((ext_vector_type(4)));
typedef unsigned u32x2 __attribute__((ext_vector_type(2)));

constexpr int T = 65536, DM = 1024, SEQ = 4096, NBATCH = 16, DIN = 2176, DINP = 2304, DFF = 2816, DEPTH = 4, DLRU = 384;
constexpr int NTHR = 512, NWAVES = 8;
constexpr int LDS_BYTES = 155648;
constexpr size_t MiB = 1u << 20;
constexpr size_t WS_WIN = 0;
constexpr size_t WS_WOUT = 18 * MiB;
constexpr size_t WS_WGU = 26 * MiB;
constexpr size_t WS_WDN = 70 * MiB;
constexpr size_t WS_WLRU = 92 * MiB;
constexpr size_t WS_WF = 93 * MiB;
constexpr size_t WS_MOD = 94 * MiB;
constexpr size_t WS_MODP = 96 * MiB;
constexpr size_t WS_CAR = 122 * MiB;
constexpr size_t WS_HIN = 128 * MiB;
constexpr size_t WS_H = 132 * MiB;
constexpr size_t WS_P = 260 * MiB;
constexpr size_t WS_Y = 548 * MiB;
constexpr size_t WS_HID = 260 * MiB;
constexpr size_t WS_BAR = 131 * MiB;
constexpr size_t WS_SS = 676 * MiB;
constexpr size_t WS_BIN = 680 * MiB;
constexpr size_t WS_BGU = 681 * MiB;
constexpr size_t WS_XB = 683 * MiB;
constexpr size_t WS_END = 811 * MiB;

struct Args { const float* in[21]; float* out; unsigned char* ws; };
constexpr size_t WS_DBG = 131 * MiB + 512 * 1024;
#ifdef DBG_FLAGS
#define DBG_CHK(dbgp, v, bit) do {} while (0)
#define DBG2(dbgp, v, bit) do { if ((dbgp) && !(fabsf(v) < 1e30f)) atomicOr((dbgp), 1u << (bit)); } while (0)
#else
#define DBG2(dbgp, v, bit) do {} while (0)
#define DBG_CHK(dbgp, v, bit) do {} while (0)
#endif

__device__ __forceinline__ float bflo(unsigned w) { return __uint_as_float(w << 16); }
__device__ __forceinline__ float bfhi(unsigned w) { return __uint_as_float(w & 0xffff0000u); }
__device__ __forceinline__ unsigned pk2(float lo, float hi) { return pg8::cvt_pk_bf16(lo, hi); }
__device__ __forceinline__ u32x2 pk4(f32x4 v) { u32x2 r; r.x = pk2(v[0], v[1]); r.y = pk2(v[2], v[3]); return r; }
__device__ __forceinline__ f32x4 mfma16(bf16x8 a, bf16x8 b, f32x4 c) { return __builtin_amdgcn_mfma_f32_16x16x32_bf16(a, b, c, 0, 0, 0); }
__device__ __forceinline__ float wave_sum(float v) {
#pragma unroll
    for (int o = 1; o < 64; o <<= 1) v += __shfl_xor(v, o);
    return v;
}
__device__ __forceinline__ float sigmoidf_(float x) { return __builtin_amdgcn_rcpf(1.0f + __expf(-x)); }
#define LDS_FRAG(p) (*(const LAS bf16x8*)(p))
#define LDS_BARRIER() do { asm volatile("s_waitcnt lgkmcnt(0)" ::: "memory"); __builtin_amdgcn_s_barrier(); asm volatile("" ::: "memory"); } while (0)

__device__ __forceinline__ void tr_item(const float* W, int K, int N, bf16* WT, int dst_row0, float scale, LAS float* scr, int kb, int nb, int lane) {
    const int k0 = 64 * kb, n0 = 32 * nb;
#pragma unroll 8
    for (int i = 0; i < 32; ++i) { const int kk = 2 * i + (lane >> 5); scr[kk * 33 + (lane & 31)] = W[(size_t)(k0 + kk) * N + n0 + (lane & 31)] * scale; }
    asm volatile("s_waitcnt lgkmcnt(0)" ::: "memory");
    const int c = lane & 7;
#pragma unroll
    for (int j = 0; j < 4; ++j) { const int n = (lane >> 3) + 8 * j; const LAS float* s = scr + (8 * c) * 33 + n;
        u32x4 o; o.x = pk2(s[0 * 33], s[1 * 33]); o.y = pk2(s[2 * 33], s[3 * 33]); o.z = pk2(s[4 * 33], s[5 * 33]); o.w = pk2(s[6 * 33], s[7 * 33]);
        *(u32x4*)(WT + (size_t)(dst_row0 + n) * K + k0 + 8 * c) = o; }
    asm volatile("s_waitcnt lgkmcnt(0)" ::: "memory");
}

__device__ __forceinline__ void phase_prologue_a(const Args& a, LAS unsigned char* lds, int tid, int wave, int lane, int G) {
    unsigned char* ws = a.ws;
    LAS float* cact = (LAS float*)lds;
    for (int i = tid; i < NBATCH * DM; i += NTHR) { const float c = a.in[1][i]; cact[i] = c * sigmoidf_(c); }
    __syncthreads();
    LAS float* scr = (LAS float*)(lds + 65536 + wave * 8448);
    const int gw = blockIdx.x * NWAVES + wave, NGW = G * NWAVES;
    constexpr int I_IN = 16 * 68, I_OUT = 16 * 32, I_G = 16 * 88, I_DN = 44 * 32, I_LRU = 24, I_F = 8;
    constexpr int PER_L = I_IN + I_OUT + 2 * I_G + I_DN + 2 * I_LRU + I_F;
    constexpr int N_TR = DEPTH * PER_L, N_MODP = DEPTH * 24 * 16;
    for (int it = gw; it < N_TR + N_MODP; it += NGW) {
        if (it < N_TR) {
            const int l = it / PER_L; int r = it % PER_L;
            if (r < I_IN) { const int kb = r / 68, nb = r % 68; const float sc = (nb >= 32 && nb < 44) ? 0.125f * 1.4426950408889634f : 1.0f;
                tr_item(a.in[6] + (size_t)l * DM * DIN, DM, DIN, (bf16*)(ws + WS_WIN) + (size_t)l * DINP * DM, 32 * nb, sc, scr, kb, nb, lane); continue; } r -= I_IN;
            if (r < I_OUT) { const int kb = r / 32, nb = r % 32;
                tr_item(a.in[16] + (size_t)l * DM * DM, DM, DM, (bf16*)(ws + WS_WOUT) + (size_t)l * DM * DM, 32 * nb, 1.0f, scr, kb, nb, lane); continue; } r -= I_OUT;
            if (r < 2 * I_G) { const int up = r >= I_G; if (up) r -= I_G; const int kb = r / 88, nb = r % 88; const int n0 = 32 * nb;
                tr_item(a.in[up ? 18 : 17] + (size_t)l * DM * DFF, DM, DFF, (bf16*)(ws + WS_WGU) + (size_t)l * 5632 * DM, 256 * (n0 >> 7) + 128 * up + (n0 & 127), 1.0f, scr, kb, nb, lane); continue; } r -= 2 * I_G;
            if (r < I_DN) { const int kb = r / 32, nb = r % 32;
                tr_item(a.in[19] + (size_t)l * DFF * DM, DFF, DM, (bf16*)(ws + WS_WDN) + (size_t)l * DM * DFF, 32 * nb, 1.0f, scr, kb, nb, lane); continue; } r -= I_DN;
            if (r < 2 * I_LRU) { const int gate = r >= I_LRU; if (gate) r -= I_LRU; const int mat = r >> 1, nb = r & 1;
                const int dir = mat / 6, h = mat % 6;
                tr_item(a.in[gate ? 12 : 10] + (size_t)((l * 2 + dir) * 6 + h) * 4096, 64, 64, (bf16*)(ws + WS_WLRU) + (size_t)((((l * 2 + dir) * 2 + gate) * 6) + h) * 4096, 32 * nb, -1.4426950408889634f, scr, 0, nb, lane); continue; } r -= 2 * I_LRU;
            { const int g = r >> 1, nb = r & 1;
                tr_item(a.in[7] + (size_t)(l * 4 + g) * 4096, 64, 64, (bf16*)(ws + WS_WF) + (size_t)(l * 4 + g) * 4096, 32 * nb, 1.0f, scr, 0, nb, lane); }
        } else {
            const int m = it - N_TR; const int ks = m & 15, cb = (m >> 4) % 24, l = (m >> 4) / 24;
            const int c0 = cb * 256 + lane * 4;
            f32x4 acc[16];
#pragma unroll
            for (int b = 0; b < 16; ++b) acc[b] = (f32x4){0.f, 0.f, 0.f, 0.f};
            const float* wp = a.in[2] + ((size_t)l * DM + ks * 64) * 6144 + c0;
#pragma unroll 4
            for (int kk = 0; kk < 64; ++kk) { const f32x4 w = *(const f32x4*)(wp + (size_t)kk * 6144);
#pragma unroll
                for (int b = 0; b < 16; ++b) { const float ca = cact[b * DM + ks * 64 + kk]; acc[b] += w * ca; } }
            float* mp = (float*)(ws + WS_MODP) + ((size_t)(ks * 64 + l * 16)) * 6144 + c0;
#pragma unroll
            for (int b = 0; b < 16; ++b) *(f32x4*)(mp + (size_t)b * 6144) = acc[b];
        }
    }
    const int gt = blockIdx.x * NTHR + tid, NGT = G * NTHR;
    for (int i = gt; i < DEPTH * 128 * DM / 8; i += NGT) { const int l = i / (128 * DM / 8), o = i % (128 * DM / 8);
        *(u32x4*)((bf16*)(ws + WS_WIN) + (size_t)l * DINP * DM + (size_t)DIN * DM + (size_t)o * 8) = (u32x4){0u, 0u, 0u, 0u}; }
}
__device__ __forceinline__ void phase_prologue_b(const Args& a, int tid, int G) {
    const int gt = blockIdx.x * NTHR + tid, NGT = G * NTHR;
    for (int i = gt; i < DEPTH * NBATCH * 6144 / 4; i += NGT) { const int flat = i * 4, j = flat % 6144, lb = flat / 6144, l = lb >> 4;
        f32x4 s = *(const f32x4*)(a.in[3] + l * 6144 + j);
#pragma unroll
        for (int ks = 0; ks < 16; ++ks) s += *(const f32x4*)((const float*)(a.ws + WS_MODP) + ((size_t)(ks * 64 + lb)) * 6144 + j);
        *(f32x4*)((float*)(a.ws + WS_MOD) + (size_t)lb * 6144 + j) = s; }
}

__device__ __forceinline__ void phase_norm(const float* xin, const float* g, const float* modl, int sh_off, int sc_off, bf16* H, int wave, int lane, int G, unsigned* dbg) {
    const int gw = blockIdx.x * NWAVES + wave, NGW = G * NWAVES;
    for (int m = gw; m < T; m += NGW) {
        const int b = m >> 12;
        const f32x4* xr = (const f32x4*)(xin + (size_t)m * DM) + lane;
        f32x4 v[4]; float ss = 0.f;
#pragma unroll
        for (int j = 0; j < 4; ++j) { v[j] = xr[64 * j]; ss += (v[j][0] * v[j][0] + v[j][1] * v[j][1]) + (v[j][2] * v[j][2] + v[j][3] * v[j][3]); }
        const float rstd = rsqrtf(wave_sum(ss) * (1.0f / DM) + 1e-6f);
        u32x2* o8 = (u32x2*)(H + (size_t)m * DM) + lane;
#pragma unroll
        for (int j = 0; j < 4; ++j) { const int col = 4 * lane + 256 * j;
            const f32x4 gv = *(const f32x4*)(g + col), sc = *(const f32x4*)(modl + b * 6144 + sc_off + col), sh = *(const f32x4*)(modl + b * 6144 + sh_off + col);
            const f32x4 y = v[j] * rstd * gv * (sc + 1.0f) + sh;
            for (int q = 0; q < 4; ++q) DBG_CHK(dbg, y[q], 0);
            o8[64 * j] = pk4(y); }
    }
}
__device__ __forceinline__ void phase_final_norm(const bf16* xb, float* out, const float* g, int wave, int lane, int G) {
    const int gw = blockIdx.x * NWAVES + wave, NGW = G * NWAVES;
    f32x4 gv[2][2];
#pragma unroll
    for (int j = 0; j < 2; ++j)
#pragma unroll
        for (int n = 0; n < 2; ++n) gv[j][n] = *(const f32x4*)(g + 8 * lane + 512 * j + 4 * n);
    u32x4 wn[2];
    if (gw < T) { wn[0] = ((const u32x4*)(xb + (size_t)gw * DM) + lane)[0]; wn[1] = ((const u32x4*)(xb + (size_t)gw * DM) + lane)[64]; }
    for (int m = gw; m < T; m += NGW) {
        const u32x4 w0 = wn[0], w1 = wn[1];
        if (m + NGW < T) { wn[0] = ((const u32x4*)(xb + (size_t)(m + NGW) * DM) + lane)[0]; wn[1] = ((const u32x4*)(xb + (size_t)(m + NGW) * DM) + lane)[64]; }
        __builtin_amdgcn_sched_barrier(0);
        f32x4 v[2][2]; float ss = 0.f;
        v[0][0] = (f32x4){bflo(w0.x), bfhi(w0.x), bflo(w0.y), bfhi(w0.y)}; v[0][1] = (f32x4){bflo(w0.z), bfhi(w0.z), bflo(w0.w), bfhi(w0.w)};
        v[1][0] = (f32x4){bflo(w1.x), bfhi(w1.x), bflo(w1.y), bfhi(w1.y)}; v[1][1] = (f32x4){bflo(w1.z), bfhi(w1.z), bflo(w1.w), bfhi(w1.w)};
#pragma unroll
        for (int j = 0; j < 2; ++j)
#pragma unroll
            for (int n = 0; n < 2; ++n) ss += (v[j][n][0] * v[j][n][0] + v[j][n][1] * v[j][n][1]) + (v[j][n][2] * v[j][n][2] + v[j][n][3] * v[j][n][3]);
        const float rstd = rsqrtf(wave_sum(ss) * (1.0f / DM) + 1e-6f);
        float* orow = out + (size_t)m * DM + 8 * lane;
#pragma unroll
        for (int j = 0; j < 2; ++j)
#pragma unroll
            for (int n = 0; n < 2; ++n) *(f32x4*)(orow + 512 * j + 4 * n) = v[j][n] * rstd * gv[j][n];
    }
}
__device__ __forceinline__ void phase_xt0(const float* xin, const float* g, const float* modl, int sc_off, bf16* H, float* SS, int wave, int lane, int G) {
    const int gw = blockIdx.x * NWAVES + wave, NGW = G * NWAVES;
    f32x4 gv[4];
#pragma unroll
    for (int j = 0; j < 4; ++j) gv[j] = *(const f32x4*)(g + 4 * lane + 256 * j);
    f32x4 vn[4];
    if (gw < T) {
#pragma unroll
        for (int j = 0; j < 4; ++j) vn[j] = ((const f32x4*)(xin + (size_t)gw * DM) + lane)[64 * j]; }
    for (int m = gw; m < T; m += NGW) {
        const int b = m >> 12;
        f32x4 v[4], sc[4];
#pragma unroll
        for (int j = 0; j < 4; ++j) { v[j] = vn[j]; sc[j] = *(const f32x4*)(modl + b * 6144 + sc_off + 4 * lane + 256 * j); }
        if (m + NGW < T) {
#pragma unroll
            for (int j = 0; j < 4; ++j) vn[j] = ((const f32x4*)(xin + (size_t)(m + NGW) * DM) + lane)[64 * j]; }
        __builtin_amdgcn_sched_barrier(0);
        u32x2* o8 = (u32x2*)(H + (size_t)m * DM) + lane;
        float ss = 0.f;
#pragma unroll
        for (int j = 0; j < 4; ++j) { ss += (v[j][0] * v[j][0] + v[j][1] * v[j][1]) + (v[j][2] * v[j][2] + v[j][3] * v[j][3]);
            o8[64 * j] = pk4(v[j] * gv[j] * (sc[j] + 1.0f)); }
        ss = wave_sum(ss);
        if (lane < 16) SS[(size_t)m * 16 + lane] = (lane == 0) ? ss : 0.f;
    }
}
__device__ __forceinline__ void phase_bias(unsigned char* ws, int wave, int lane, int G) {
    const int gw = blockIdx.x * NWAVES + wave, NGW = G * NWAVES, fr = lane & 15, fq = lane >> 4;
    constexpr int TIN = DINP / 16, TGU = 5632 / 16, PER_L = TIN + TGU;
    for (int it = gw; it < DEPTH * PER_L; it += NGW) {
        const int l = it / PER_L; int r = it % PER_L; const bool gu = r >= TIN; if (gu) r -= TIN;
        const bf16* Wt = gu ? (const bf16*)(ws + WS_WGU) + (size_t)l * 5632 * DM : (const bf16*)(ws + WS_WIN) + (size_t)l * DINP * DM;
        const float* sh = (const float*)(ws + WS_MOD) + (size_t)l * NBATCH * 6144 + (gu ? 3072 : 0) + (size_t)fr * 6144 + 8 * fq;
        const bf16* wp = Wt + (size_t)(16 * r + fr) * DM + 8 * fq;
        f32x4 acc = (f32x4){0.f, 0.f, 0.f, 0.f};
#pragma unroll 4
        for (int ks = 0; ks < 32; ++ks) { const bf16x8 wf = *(const bf16x8*)(wp + 32 * ks);
            const f32x4 s0 = *(const f32x4*)(sh + 32 * ks), s1 = *(const f32x4*)(sh + 32 * ks + 4);
            u32x4 sw; sw.x = pk2(s0[0], s0[1]); sw.y = pk2(s0[2], s0[3]); sw.z = pk2(s1[0], s1[1]); sw.w = pk2(s1[2], s1[3]);
            acc = mfma16(wf, __builtin_bit_cast(bf16x8, sw), acc); }
        float* dst = gu ? (float*)(ws + WS_BGU) + ((size_t)l * NBATCH + fr) * 5632 : (float*)(ws + WS_BIN) + ((size_t)l * NBATCH + fr) * DINP;
        *(f32x4*)(dst + 16 * r + 4 * fq) = acc;
    }
}

constexpr int F_C = 0, F_S = 9216, F_NS = 18432, F_T0 = 27648, F_T1 = 36864, F_T2 = 46080, F_T3 = 55296, F_W = 64512;
__device__ __forceinline__ void build_dft_tables(LAS unsigned char* lds, int tid) {
    for (int i = tid; i < 4096; i += NTHR) { const int r = i >> 6, c = i & 63, m = (r * c) & 63; const float ang = (float)m * (1.0f / 32.0f);
        const float cs = cospif(ang), sn = sinpif(ang);
        const unsigned pc = pk2(cs, sn), pn = pk2(-sn, 0.f);
        *(LAS bf16*)(lds + F_C + r * 144 + c * 2) = (bf16)(pc & 0xffffu);
        *(LAS bf16*)(lds + F_S + r * 144 + c * 2) = (bf16)(pc >> 16);
        *(LAS bf16*)(lds + F_NS + r * 144 + c * 2) = (bf16)(pn & 0xffffu); }
}
__device__ __forceinline__ u32x4 fourier1_load(const bf16* P, int item, int tid) {
    const int s2 = item & 63, bg = item >> 6, g = bg & 3, b = bg >> 2, s1 = tid >> 3, c8 = tid & 7;
    return *(const u32x4*)(P + (size_t)(b * SEQ + 64 * s1 + s2) * DINP + 64 * g + 8 * c8);
}
__device__ __forceinline__ void fourier1_item(LAS unsigned char* lds, u32x4 vpre, bf16* Z2, int item, int tid, int wave, int lane, unsigned* dbg) {
    const int s2 = item & 63, bg = item >> 6, g = bg & 3, b = bg >> 2, fr = lane & 15, fq = lane >> 4;
    { const int s1 = tid >> 3, c8 = tid & 7; *(LAS u32x4*)(lds + F_T0 + s1 * 144 + c8 * 16) = vpre; }
    LDS_BARRIER();
    const int ib = wave >> 1;
    { const bf16x8 x0 = LDS_FRAG(lds + F_T0 + (16 * ib + fr) * 144 + fq * 16), x1 = LDS_FRAG(lds + F_T0 + (16 * ib + fr) * 144 + fq * 16 + 64);
#pragma unroll
      for (int jj = 0; jj < 2; ++jj) { const int jb = 2 * (wave & 1) + jj, off = (16 * jb + fr) * 144 + fq * 16;
          const bf16x8 c0 = LDS_FRAG(lds + F_C + off), c1 = LDS_FRAG(lds + F_C + off + 64), n0 = LDS_FRAG(lds + F_NS + off), n1 = LDS_FRAG(lds + F_NS + off + 64);
          f32x4 aA = mfma16(x0, c0, (f32x4){0.f, 0.f, 0.f, 0.f}); aA = mfma16(x1, c1, aA);
          f32x4 aB = mfma16(x0, n0, (f32x4){0.f, 0.f, 0.f, 0.f}); aB = mfma16(x1, n1, aB);
          for (int q = 0; q < 4; ++q) { DBG2(dbg, aA[q], 1); DBG2(dbg, aB[q], 1); }
          const int so = (16 * jb + fr) * 144 + (16 * ib + 4 * fq) * 2;
          *(LAS u32x2*)(lds + F_T2 + so) = pk4(aA); *(LAS u32x2*)(lds + F_T3 + so) = pk4(aB); } }
    LDS_BARRIER();
    { const int ao = (16 * ib + fr) * 144 + fq * 16;
      const bf16x8 a0 = LDS_FRAG(lds + F_T2 + ao), a1 = LDS_FRAG(lds + F_T2 + ao + 64), b0 = LDS_FRAG(lds + F_T3 + ao), b1 = LDS_FRAG(lds + F_T3 + ao + 64);
#pragma unroll
      for (int jj = 0; jj < 2; ++jj) { const int jb = 2 * (wave & 1) + jj, off = (16 * jb + fr) * 144 + fq * 16;
          const bf16x8 c0 = LDS_FRAG(lds + F_C + off), c1 = LDS_FRAG(lds + F_C + off + 64), s0 = LDS_FRAG(lds + F_S + off), s1 = LDS_FRAG(lds + F_S + off + 64),
                       n0 = LDS_FRAG(lds + F_NS + off), n1 = LDS_FRAG(lds + F_NS + off + 64);
          f32x4 zr = mfma16(a0, c0, (f32x4){0.f, 0.f, 0.f, 0.f}); zr = mfma16(a1, c1, zr); zr = mfma16(b0, s0, zr); zr = mfma16(b1, s1, zr);
          f32x4 zi = mfma16(b0, c0, (f32x4){0.f, 0.f, 0.f, 0.f}); zi = mfma16(b1, c1, zi); zi = mfma16(a0, n0, zi); zi = mfma16(a1, n1, zi);
          for (int q = 0; q < 4; ++q) { DBG2(dbg, zr[q], 2); DBG2(dbg, zi[q], 2); }
          const int k1 = 16 * jb + fr; const float ang = (float)(s2 * k1) * (1.0f / 2048.0f); const float ct = cospif(ang), st = sinpif(ang);
          const f32x4 wr_ = zr * ct + zi * st, wi_ = zi * ct - zr * st;
          for (int q = 0; q < 4; ++q) { DBG2(dbg, wr_[q], 3); DBG2(dbg, wi_[q], 3); }
          bf16* dst = Z2 + ((size_t)((bg * 64 + k1) * 64 + s2)) * 128 + 16 * ib + 4 * fq;
          *(u32x2*)dst = pk4(wr_); *(u32x2*)(dst + 64) = pk4(wi_); } }
}
struct F2Pre { u32x4 re, im, w; };
__device__ __forceinline__ F2Pre fourier2_load(const bf16* Z2, const bf16* WFl, int item, int tid) {
    const int g = (item >> 6) & 3, s2 = tid >> 3, c8 = tid & 7;
    const bf16* src = Z2 + ((size_t)(item * 64 + s2)) * 128 + 8 * c8;
    F2Pre p; p.re = *(const u32x4*)src; p.im = *(const u32x4*)(src + 64); p.w = *(const u32x4*)(WFl + g * 4096 + s2 * 64 + 8 * c8); return p;
}
__device__ __forceinline__ void fourier2_item(LAS unsigned char* lds, const F2Pre pre, bf16* Y, int item, int tid, int wave, int lane, unsigned* dbg) {
    const int k1 = item & 63, bg = item >> 6, g = bg & 3, b = bg >> 2, fr = lane & 15, fq = lane >> 4;
    { const int s2 = tid >> 3, c8 = tid & 7;
      *(LAS u32x4*)(lds + F_T0 + s2 * 144 + c8 * 16) = pre.re; *(LAS u32x4*)(lds + F_T1 + s2 * 144 + c8 * 16) = pre.im; *(LAS u32x4*)(lds + F_W + s2 * 144 + c8 * 16) = pre.w; }
    LDS_BARRIER();
    const int ib = wave >> 1;
    { const int xo = (16 * ib + fr) * 144 + fq * 16;
      const bf16x8 r0 = LDS_FRAG(lds + F_T0 + xo), r1 = LDS_FRAG(lds + F_T0 + xo + 64), i0 = LDS_FRAG(lds + F_T1 + xo), i1 = LDS_FRAG(lds + F_T1 + xo + 64);
#pragma unroll
      for (int jj = 0; jj < 2; ++jj) { const int jb = 2 * (wave & 1) + jj, off = (16 * jb + fr) * 144 + fq * 16;
          const bf16x8 w0 = LDS_FRAG(lds + F_W + off), w1 = LDS_FRAG(lds + F_W + off + 64);
          f32x4 qr = mfma16(r0, w0, (f32x4){0.f, 0.f, 0.f, 0.f}); qr = mfma16(r1, w1, qr);
          f32x4 qi = mfma16(i0, w0, (f32x4){0.f, 0.f, 0.f, 0.f}); qi = mfma16(i1, w1, qi);
          for (int q = 0; q < 4; ++q) { DBG2(dbg, qr[q], 5); DBG2(dbg, qi[q], 5); }
          const int so = (16 * jb + fr) * 144 + (16 * ib + 4 * fq) * 2;
          *(LAS u32x2*)(lds + F_T2 + so) = pk4(qr); *(LAS u32x2*)(lds + F_T3 + so) = pk4(qi); } }
    LDS_BARRIER();
    { const int ao = (16 * ib + fr) * 144 + fq * 16;
      const bf16x8 a0 = LDS_FRAG(lds + F_T2 + ao), a1 = LDS_FRAG(lds + F_T2 + ao + 64), b0 = LDS_FRAG(lds + F_T3 + ao), b1 = LDS_FRAG(lds + F_T3 + ao + 64);
#pragma unroll
      for (int jj = 0; jj < 2; ++jj) { const int jb = 2 * (wave & 1) + jj, off = (16 * jb + fr) * 144 + fq * 16;
          const bf16x8 c0 = LDS_FRAG(lds + F_C + off), c1 = LDS_FRAG(lds + F_C + off + 64), s0 = LDS_FRAG(lds + F_S + off), s1 = LDS_FRAG(lds + F_S + off + 64);
          f32x4 x = mfma16(a0, c0, (f32x4){0.f, 0.f, 0.f, 0.f}); x = mfma16(a1, c1, x); x = mfma16(b0, s0, x); x = mfma16(b1, s1, x);
          const int k2 = 16 * jb + fr;
          for (int q = 0; q < 8; ++q) { DBG2(dbg, bflo((unsigned)(unsigned short)c0[q]), 0); DBG2(dbg, bflo((unsigned)(unsigned short)c1[q]), 0); DBG2(dbg, bflo((unsigned)(unsigned short)s0[q]), 1); DBG2(dbg, bflo((unsigned)(unsigned short)s1[q]), 1);
              DBG2(dbg, bflo((unsigned)(unsigned short)a0[q]), 2); DBG2(dbg, bflo((unsigned)(unsigned short)a1[q]), 2); DBG2(dbg, bflo((unsigned)(unsigned short)b0[q]), 3); DBG2(dbg, bflo((unsigned)(unsigned short)b1[q]), 3); }
          for (int q = 0; q < 4; ++q) DBG2(dbg, x[q], 4);
          *(u32x2*)(Y + (size_t)(b * SEQ + k1 + 64 * k2) * DM + 64 * g + 16 * ib + 4 * fq) = pk4(x * (1.0f / 512.0f)); } }
}

constexpr int L_UB = 0, L_UF = 9216, L_AB = 26624, L_ARR = 17408, L_SEG = 96256;
struct LruPtrs { const bf16* P; const bf16* WL; const float *cw, *cb, *ba, *bx, *lam; float* car; const float* hin; bf16* Y; unsigned* dbg; };
__device__ __forceinline__ float one_minus_exp(float w) {
    const float ser = -w * (1.0f + w * (0.5f + w * (0.16666667f + w * 0.041666668f)));
    return (w > -0.03f) ? ser : 1.0f - __expf(w);
}
template <int PASS> __device__ __forceinline__ void lru_phase(LAS unsigned char* lds, const LruPtrs& q, int l, int tid, int wave, int lane, int G) {
    constexpr int NIT = NBATCH * 64 * 6;
    const int fr = lane & 15, fq = lane >> 4;
    const int ct = tid >> 3, c8 = tid & 7;
    const int gdir = wave >> 2, geb = wave & 3;
    const int e0 = 16 * geb + 4 * fq;
    float cw[4][8], cbv[8];
    bf16x8 wa0, wa1, wx0, wx1; f32x4 ba, bx, sp;
    int hcur = -1;
    u32x4 pxn[4]; u32x4 pgn; float hinn = 0.f;
    int it = blockIdx.x;
    auto issue = [&](int item) {
        const int h = item >> 10, br = item & 1023, r = br & 63, b = br >> 6;
        const int ch0 = 64 * h + 8 * c8;
#pragma unroll
        for (int k = 0; k < 4; ++k) { const int s = 64 * r + ct + k - 2; const int sc = min(max(s, 0), SEQ - 1);
            pxn[k] = *(const u32x4*)(q.P + (size_t)(b * SEQ + sc) * DINP + 256 + ch0); }
        if (PASS == 2) { pgn = *(const u32x4*)(q.P + (size_t)(b * SEQ + 64 * r + ct) * DINP + 640 + ch0);
            hinn = q.hin[((b * 64 + r) * 2 + (wave >> 2)) * DLRU + 64 * h + lane]; }
    };
    if (it < NIT) issue(it);
    for (; it < NIT; it += G) {
        const int h = it >> 10, br = it & 1023, r = br & 63, b = br >> 6;
        const int t0 = b * SEQ + 64 * r;
        if (h != hcur) { hcur = h;
            const int ch0 = 64 * h + 8 * c8;
#pragma unroll
            for (int k = 0; k < 4; ++k) { const f32x4 w0 = *(const f32x4*)(q.cw + (l * 4 + k) * DLRU + ch0), w1 = *(const f32x4*)(q.cw + (l * 4 + k) * DLRU + ch0 + 4);
                cw[k][0] = w0[0]; cw[k][1] = w0[1]; cw[k][2] = w0[2]; cw[k][3] = w0[3]; cw[k][4] = w1[0]; cw[k][5] = w1[1]; cw[k][6] = w1[2]; cw[k][7] = w1[3]; }
            { const f32x4 c0 = *(const f32x4*)(q.cb + l * DLRU + ch0), c1 = *(const f32x4*)(q.cb + l * DLRU + ch0 + 4);
              cbv[0] = c0[0]; cbv[1] = c0[1]; cbv[2] = c0[2]; cbv[3] = c0[3]; cbv[4] = c1[0]; cbv[5] = c1[1]; cbv[6] = c1[2]; cbv[7] = c1[3]; }
            const bf16* Wa = q.WL + (size_t)((((l * 2 + gdir) * 2 + 0) * 6) + h) * 4096 + (16 * geb + fr) * 64 + 8 * fq;
            const bf16* Wx = q.WL + (size_t)((((l * 2 + gdir) * 2 + 1) * 6) + h) * 4096 + (16 * geb + fr) * 64 + 8 * fq;
            wa0 = *(const bf16x8*)Wa; wa1 = *(const bf16x8*)(Wa + 32); wx0 = *(const bf16x8*)Wx; wx1 = *(const bf16x8*)(Wx + 32);
            const int chg = (l * 2 + gdir) * DLRU + 64 * h + e0;
            ba = *(const f32x4*)(q.ba + chg) * -1.4426950408889634f; bx = *(const f32x4*)(q.bx + chg) * -1.4426950408889634f;
            const f32x4 lam = *(const f32x4*)(q.lam + chg);
#pragma unroll
            for (int j = 0; j < 4; ++j) sp[j] = -8.0f * 1.4426950408889634f * log1pf(expf(-lam[j])); }
        { float u[8];
#pragma unroll
          for (int j = 0; j < 8; ++j) u[j] = cbv[j];
#pragma unroll
          for (int k = 0; k < 4; ++k) { const int sq = 64 * r + ct + k - 2; const bool inb = (sq >= 0) && (sq < SEQ);
              u32x4 raw = pxn[k]; if (!inb) raw = (u32x4){0u, 0u, 0u, 0u};
              u[0] += cw[k][0] * bflo(raw.x); u[1] += cw[k][1] * bfhi(raw.x); u[2] += cw[k][2] * bflo(raw.y); u[3] += cw[k][3] * bfhi(raw.y);
              u[4] += cw[k][4] * bflo(raw.z); u[5] += cw[k][5] * bfhi(raw.z); u[6] += cw[k][6] * bflo(raw.w); u[7] += cw[k][7] * bfhi(raw.w); }
          u32x4 pb; pb.x = pk2(u[0], u[1]); pb.y = pk2(u[2], u[3]); pb.z = pk2(u[4], u[5]); pb.w = pk2(u[6], u[7]);
          *(LAS u32x4*)(lds + L_UB + ct * 144 + c8 * 16) = pb;
          *(LAS f32x4*)(lds + L_UF + (ct * 68 + 8 * c8) * 4) = (f32x4){u[0], u[1], u[2], u[3]};
          *(LAS f32x4*)(lds + L_UF + (ct * 68 + 8 * c8 + 4) * 4) = (f32x4){u[4], u[5], u[6], u[7]}; }
        const u32x4 graw = pgn; const float hin_cur = hinn;
        if (it + G < NIT) issue(it + G);
        LDS_BARRIER();
        { LAS unsigned char* Aa = lds + L_AB + gdir * 2 * L_ARR; LAS unsigned char* Bb = Aa + L_ARR;
#pragma unroll
          for (int tb = 0; tb < 4; ++tb) { const int t = 16 * tb + fr;
              const bf16x8 u0 = LDS_FRAG(lds + L_UB + t * 144 + fq * 16), u1 = LDS_FRAG(lds + L_UB + t * 144 + fq * 16 + 64);
              f32x4 ga = mfma16(wa0, u0, (f32x4){0.f, 0.f, 0.f, 0.f}); ga = mfma16(wa1, u1, ga);
              f32x4 gx = mfma16(wx0, u0, (f32x4){0.f, 0.f, 0.f, 0.f}); gx = mfma16(wx1, u1, gx);
              const f32x4 uf = *(const LAS f32x4*)(lds + L_UF + (t * 68 + e0) * 4);
              f32x4 av, bv;
#pragma unroll
              for (int j = 0; j < 4; ++j) {
                  const float d1 = 1.0f + __builtin_amdgcn_exp2f(fminf(ga[j] + ba[j], 30.0f)), d2 = 1.0f + __builtin_amdgcn_exp2f(fminf(gx[j] + bx[j], 30.0f));
                  const float rc = __builtin_amdgcn_rcpf(d1 * d2), rg = rc * d2, ig = rc * d1;
                  const float aa = __builtin_amdgcn_exp2f(rg * sp[j]);
                  av[j] = aa; bv[j] = __builtin_amdgcn_sqrtf(fmaf(-aa, aa, 1.0f)) * (ig * uf[j]); }
              *(LAS f32x4*)(Aa + (t * 68 + e0) * 4) = av; *(LAS f32x4*)(Bb + (t * 68 + e0) * 4) = bv; } }
        LDS_BARRIER();
        { const int dir = wave >> 2, seg = wave & 3, e = lane;
          const LAS float* ap = (const LAS float*)(lds + L_AB + dir * 2 * L_ARR) + (16 * seg) * 68 + e;
          LAS float* bp = (LAS float*)(lds + L_AB + dir * 2 * L_ARR + L_ARR) + (16 * seg) * 68 + e;
          float av[16], bv[16];
#pragma unroll
          for (int i = 0; i < 16; ++i) { av[i] = ap[i * 68]; bv[i] = bp[i * 68]; }
          float Pm = 1.f, H = 0.f;
          if (dir == 0) {
#pragma unroll
              for (int i = 0; i < 16; ++i) { H = av[i] * H + bv[i]; Pm *= av[i]; } }
          else {
#pragma unroll
              for (int i = 15; i >= 0; --i) { H = av[i] * H + bv[i]; Pm *= av[i]; } }
          typedef float f32x2v __attribute__((ext_vector_type(2)));
          LAS f32x2v* sg = (LAS f32x2v*)(lds + L_SEG);
          sg[(dir * 4 + seg) * 64 + e] = (f32x2v){Pm, H};
          LDS_BARRIER();
          if (PASS == 1) {
              if (seg == 0) { float Pc = 1.f, Hc = 0.f;
#pragma unroll
                  for (int s = 0; s < 4; ++s) { const f32x2v ph = sg[(dir * 4 + (dir == 0 ? s : 3 - s)) * 64 + e]; Hc = ph.x * Hc + ph.y; Pc *= ph.x; }
                  *(float2*)(q.car + 2 * (size_t)(((b * 64 + r) * 2 + dir) * DLRU + 64 * h + e)) = make_float2(Pc, Hc); }
          } else {
              float Hc = hin_cur;
#pragma unroll
              for (int s = 0; s < 3; ++s) { const int sidx = (dir == 0) ? s : 3 - s; const bool use = (dir == 0) ? (s < seg) : (sidx > seg);
                  const f32x2v ph = sg[(dir * 4 + sidx) * 64 + e]; if (use) Hc = ph.x * Hc + ph.y; }
              if (dir == 0) {
#pragma unroll
                  for (int i = 0; i < 16; ++i) { Hc = av[i] * Hc + bv[i]; bp[i * 68] = Hc; } }
              else {
#pragma unroll
                  for (int i = 15; i >= 0; --i) { Hc = av[i] * Hc + bv[i]; bp[i * 68] = Hc; } }
          } }
        if (PASS == 2) {
            LDS_BARRIER();
            const size_t tok = (size_t)(t0 + ct);
            const LAS float* B0 = (const LAS float*)(lds + L_AB + L_ARR) + ct * 68 + 8 * c8; const LAS float* B1 = (const LAS float*)(lds + L_AB + 3 * L_ARR) + ct * 68 + 8 * c8;
            const f32x4 h0 = *(const LAS f32x4*)B0 + *(const LAS f32x4*)B1, h1 = *(const LAS f32x4*)(B0 + 4) + *(const LAS f32x4*)(B1 + 4);
            float gv[8] = {bflo(graw.x), bfhi(graw.x), bflo(graw.y), bfhi(graw.y), bflo(graw.z), bfhi(graw.z), bflo(graw.w), bfhi(graw.w)};
            float hs[8] = {h0[0], h0[1], h0[2], h0[3], h1[0], h1[1], h1[2], h1[3]}, y[8];
#pragma unroll
            for (int j = 0; j < 8; ++j) { const float x = gv[j], z = 0.7978845608028654f * (x + 0.044715f * x * x * x); y[j] = x * sigmoidf_(2.0f * z) * hs[j]; }
            u32x4 o; o.x = pk2(y[0], y[1]); o.y = pk2(y[2], y[3]); o.z = pk2(y[4], y[5]); o.w = pk2(y[6], y[7]);
            *(u32x4*)(q.Y + tok * DM + 256 + 64 * h + 8 * c8) = o;
        }
        LDS_BARRIER();
    }
}
__device__ __forceinline__ void lru_carry_scan(const float* car, float* hin, int tid) {
    const int gt = blockIdx.x * NTHR + tid;
    if (gt < NBATCH * 2 * DLRU) { const int ch = gt % DLRU, dir = (gt / DLRU) & 1, b = gt / (2 * DLRU);
        typedef float f32x2c __attribute__((ext_vector_type(2)));
        float H = 0.f;
#pragma unroll 1
        for (int rb = 0; rb < 4; ++rb) {
            f32x2c pe[16];
#pragma unroll
            for (int k = 0; k < 16; ++k) { const int r = (dir == 0) ? (16 * rb + k) : (63 - 16 * rb - k);
                pe[k] = *(const f32x2c*)(car + 2 * (size_t)(((b * 64 + r) * 2 + dir) * DLRU + ch)); }
            __builtin_amdgcn_sched_barrier(0);
#pragma unroll
            for (int k = 0; k < 16; ++k) { const int r = (dir == 0) ? (16 * rb + k) : (63 - 16 * rb - k);
                hin[((b * 64 + r) * 2 + dir) * DLRU + ch] = H; H = pe[k].x * H + pe[k].y; }
            __builtin_amdgcn_sched_barrier(0); } }
}

constexpr int N_K = 0, N_V = 73728, N_VS = 584, N_RPB = 148480;
constexpr float LOG2E = 1.4426950408889634f;
__device__ __forceinline__ void na_store_row(LAS unsigned char* lds, int slot, int col, int ch, u32x4 kraw, u32x4 vraw) {
    const int key = slot * 64 + col;
    *(LAS u32x4*)(lds + N_K + key * 128 + ((ch ^ (key & 7)) << 4)) = kraw;
    LAS bf16* vt = (LAS bf16*)(lds + N_V) + (8 * ch) * N_VS + key;
    vt[0 * N_VS] = (bf16)(vraw.x & 0xffffu); vt[1 * N_VS] = (bf16)(vraw.x >> 16); vt[2 * N_VS] = (bf16)(vraw.y & 0xffffu); vt[3 * N_VS] = (bf16)(vraw.y >> 16);
    vt[4 * N_VS] = (bf16)(vraw.z & 0xffffu); vt[5 * N_VS] = (bf16)(vraw.z >> 16); vt[6 * N_VS] = (bf16)(vraw.w & 0xffffu); vt[7 * N_VS] = (bf16)(vraw.w >> 16);
}
__device__ __forceinline__ void na_phase(LAS unsigned char* lds, const bf16* P, const float* rpb, bf16* Y, int tid, int wave, int lane, int G) {
    const int fr = lane & 15, fq = lane >> 4;
    const int rsel = wave >> 2, qb = wave & 3;
    const int kstart = min(max(16 * qb - 8, 0), 32);
    const int c = 16 * qb + fr, cs = min(max(c - 8, 0), 48);
    float madd[2][4]; int dcc[2][4];
#pragma unroll
    for (int t = 0; t < 2; ++t)
#pragma unroll
        for (int j = 0; j < 4; ++j) { const int kc = kstart + 16 * t + 4 * fq + j; madd[t][j] = (kc >= cs && kc < cs + 16) ? 0.0f : -1e30f; dcc[t][j] = min(max(kc - c + 15, 0), 30); }
    const int lcol = tid >> 3, lch = tid & 7;
    const LAS float* rl = (const LAS float*)(lds + N_RPB);
    for (int run = blockIdx.x; run < NBATCH * 6 * 8; run += G) {
        const int bh = run >> 3, kq = run & 7, h = bh % 6, b = bh / 6;
        const bf16* Pb = P + (size_t)b * SEQ * DINP + 64 * h;
        LDS_BARRIER();
        { const int bl0 = min(max(8 * kq - 4, 0), 56);
          u32x4 kk[9], vv[9];
#pragma unroll
          for (int i = 0; i < 9; ++i) { const bf16* src = Pb + (size_t)((bl0 + i) * 64 + lcol) * DINP + 8 * lch;
              kk[i] = *(const u32x4*)(src + 1408); vv[i] = *(const u32x4*)(src + 1792); }
          __builtin_amdgcn_sched_barrier(0);
#pragma unroll
          for (int i = 0; i < 9; ++i) na_store_row(lds, (bl0 + i) % 9, lcol, lch, kk[i], vv[i]);
          if (tid < 465) ((LAS float*)(lds + N_RPB))[tid] = rpb[h * 465 + tid] * LOG2E; }
        bf16x8 qn0, qn1;
        { const bf16* qp = Pb + (size_t)((8 * kq + rsel) * 64 + c) * DINP + 1024 + 8 * fq; qn0 = *(const bf16x8*)qp; qn1 = *(const bf16x8*)(qp + 32); }
        LDS_BARRIER();
#pragma unroll 1
        for (int i = 0; i < 4; ++i) {
            const int r0 = 8 * kq + 2 * i, band_lo = min(max(r0 - 4, 0), 56);
            const bool more = i < 3; const int bln = min(max(r0 - 2, 0), 56); const bool shift = more && (bln != band_lo);
            const bf16x8 q0 = qn0, q1 = qn1;
            u32x4 kpre[2], vpre[2];
            if (more) { const bf16* qp = Pb + (size_t)((r0 + 2 + rsel) * 64 + c) * DINP + 1024 + 8 * fq; qn0 = *(const bf16x8*)qp; qn1 = *(const bf16x8*)(qp + 32); }
#pragma unroll
            for (int j = 0; j < 2; ++j) { const int grow = min(band_lo + 9 + j, 63); const bf16* src = Pb + (size_t)(grow * 64 + lcol) * DINP + 8 * lch;
                if (shift) { kpre[j] = *(const u32x4*)(src + 1408); vpre[j] = *(const u32x4*)(src + 1792); } }
            { const int r = r0 + rsel, rs = min(max(r - 4, 0), 56);
              const int slot0 = rs % 9;
              f32x4 s[8][2]; float mx = -1e30f;
#pragma unroll
              for (int g2 = 0; g2 < 4; ++g2) {
                  bf16x8 kf[2][2][2]; float bw[2][2][4];
#pragma unroll
                  for (int u = 0; u < 2; ++u) { const int kr = 2 * g2 + u; int slot = slot0 + kr; slot = (slot >= 9) ? slot - 9 : slot; const int dr31 = (rs + kr - r + 7) * 31;
#pragma unroll
                      for (int t = 0; t < 2; ++t) { const int key = slot * 64 + kstart + 16 * t + fr; const LAS unsigned char* ka = lds + N_K + key * 128;
                          kf[u][t][0] = LDS_FRAG(ka + ((fq ^ (key & 7)) << 4)); kf[u][t][1] = LDS_FRAG(ka + (((4 + fq) ^ (key & 7)) << 4));
#pragma unroll
                          for (int j = 0; j < 4; ++j) bw[u][t][j] = rl[dr31 + dcc[t][j]]; } }
                  __builtin_amdgcn_sched_barrier(0);
#pragma unroll
                  for (int u = 0; u < 2; ++u)
#pragma unroll
                      for (int t = 0; t < 2; ++t) { f32x4 acc = mfma16(kf[u][t][0], q0, (f32x4){0.f, 0.f, 0.f, 0.f}); acc = mfma16(kf[u][t][1], q1, acc);
#pragma unroll
                          for (int j = 0; j < 4; ++j) { const float v = (acc[j] + bw[u][t][j]) + madd[t][j]; acc[j] = v; mx = fmaxf(mx, v); }
                          s[2 * g2 + u][t] = acc; }
                  __builtin_amdgcn_sched_barrier(0); }
              mx = fmaxf(mx, __shfl_xor(mx, 16)); mx = fmaxf(mx, __shfl_xor(mx, 32));
              float sum = 0.f;
#pragma unroll
              for (int kr = 0; kr < 8; ++kr)
#pragma unroll
                  for (int t = 0; t < 2; ++t)
#pragma unroll
                      for (int j = 0; j < 4; ++j) { const float p = __builtin_amdgcn_exp2f(s[kr][t][j] - mx); s[kr][t][j] = p; sum += p; }
              sum += __shfl_xor(sum, 16); sum += __shfl_xor(sum, 32);
              f32x4 O[4];
#pragma unroll
              for (int db = 0; db < 4; ++db) O[db] = (f32x4){0.f, 0.f, 0.f, 0.f};
              const LAS bf16* vbase = (const LAS bf16*)(lds + N_V) + fr * N_VS + kstart + 4 * fq;
              u32x2 va[2][4], vb[2][4];
#pragma unroll
              for (int db = 0; db < 4; ++db) { const LAS bf16* vp = vbase + 16 * db * N_VS + slot0 * 64; va[0][db] = *(const LAS u32x2*)vp; vb[0][db] = *(const LAS u32x2*)(vp + 16); }
#pragma unroll
              for (int kr = 0; kr < 8; ++kr) {
                  if (kr < 7) { int slot = slot0 + kr + 1; slot = (slot >= 9) ? slot - 9 : slot;
#pragma unroll
                      for (int db = 0; db < 4; ++db) { const LAS bf16* vp = vbase + 16 * db * N_VS + slot * 64; va[(kr + 1) & 1][db] = *(const LAS u32x2*)vp; vb[(kr + 1) & 1][db] = *(const LAS u32x2*)(vp + 16); } }
                  __builtin_amdgcn_sched_barrier(0);
                  const u32x2 pa = pk4(s[kr][0]), pb = pk4(s[kr][1]); u32x4 pw; pw.x = pa.x; pw.y = pa.y; pw.z = pb.x; pw.w = pb.y;
                  const bf16x8 pf = __builtin_bit_cast(bf16x8, pw);
#pragma unroll
                  for (int db = 0; db < 4; ++db) { u32x4 vw; vw.x = va[kr & 1][db].x; vw.y = va[kr & 1][db].y; vw.z = vb[kr & 1][db].x; vw.w = vb[kr & 1][db].y;
                      O[db] = mfma16(__builtin_bit_cast(bf16x8, vw), pf, O[db]); }
                  __builtin_amdgcn_sched_barrier(0); }
              const float inv = __builtin_amdgcn_rcpf(sum);
              bf16* yp = Y + (size_t)(b * SEQ + r * 64 + c) * DM + 640 + 64 * h + 4 * fq;
#pragma unroll
              for (int db = 0; db < 4; ++db) *(u32x2*)(yp + 16 * db) = pk4(O[db] * inv); }
            if (more) {
                LDS_BARRIER();
                if (shift) {
#pragma unroll
                    for (int j = 0; j < 2; ++j) { const int grow = band_lo + 9 + j; if (grow <= 63) na_store_row(lds, grow % 9, lcol, lch, kpre[j], vpre[j]); } }
                LDS_BARRIER();
            }
        }
    }
    LDS_BARRIER();
}

typedef __attribute__((address_space(1))) unsigned gu32;
#define RLX_AGENT __ATOMIC_RELAXED, __HIP_MEMORY_SCOPE_AGENT
#define XB_TMO      128
#define XB_XCNT(j)  (256  + 64 * (j))
#define XB_XSUB(j)  (1280 + 64 * (j))
#define XB_XGEN(j)  (2304 + 64 * (j))
#define XB_TOP      3328
#define XB_TOPGEN   3392
#define XCD_BAR_WORDS 3456
#define XB_SPIN_CAP (1u << 18)

__device__ __forceinline__ unsigned xb_ld(unsigned* p)              { return __hip_atomic_load(p, __ATOMIC_RELAXED, __HIP_MEMORY_SCOPE_AGENT); }
__device__ __forceinline__ unsigned xb_add(unsigned* p, unsigned v) { return __hip_atomic_fetch_add(p, v, __ATOMIC_RELAXED, __HIP_MEMORY_SCOPE_AGENT); }
__device__ __forceinline__ unsigned xb_xcc_id() { return (unsigned)__builtin_amdgcn_s_getreg((3 << 11) | 20) & 0xFu; }
#define XB_SPIN(cond, bar) do { unsigned _sp = 0; while (cond) { __builtin_amdgcn_s_sleep(1); \
    if ((++_sp & 255u) == 0u) { if (xb_ld(&(bar)[XB_TMO])) break; if (_sp > XB_SPIN_CAP) { atomicAdd(&(bar)[XB_TMO], 1u); break; } } } } while (0)

struct XcdBarrier {
    unsigned* bar; unsigned x;
    volatile LAS unsigned* st;
};

__device__ __forceinline__ XcdBarrier xcd_barrier_post(unsigned* bar, volatile LAS unsigned* st) {
    XcdBarrier b; b.bar = bar; b.x = xb_xcc_id(); b.st = st;
    if (threadIdx.x == 0) (void)xb_add(&bar[XB_XCNT(b.x)], 1u);
    return b;
}
__device__ __forceinline__ void xcd_barrier_complete(unsigned* bar, unsigned x, unsigned& nloc, unsigned& nx) {
    const unsigned G = gridDim.x * gridDim.y * gridDim.z;
    unsigned sum, cnt, mine, sp = 0u;
    for (;;) {
        sum = 0u; cnt = 0u; mine = 0u;
#pragma unroll
        for (unsigned j = 0; j < 16; ++j) { const unsigned c = xb_ld(&bar[XB_XCNT(j)]); sum += c; cnt += (c > 0u) ? 1u : 0u; mine = (j == x) ? c : mine; }
        if (sum == G) break;
        __builtin_amdgcn_s_sleep(1);
        if ((++sp & 255u) == 0u) { if (xb_ld(&bar[XB_TMO])) break; if (sp > XB_SPIN_CAP) { atomicAdd(&bar[XB_TMO], 1u); break; } }
    }
    nloc = mine > 0u ? mine : 1u; nx = cnt > 0u ? cnt : 1u;
}

__device__ __forceinline__ void xcd_barrier(const XcdBarrier& b) {
    asm volatile("s_waitcnt vmcnt(0)" ::: "memory");
    __syncthreads();
    if (threadIdx.x == 0) {
        unsigned* bar = b.bar;
        __builtin_amdgcn_s_waitcnt(0);
        unsigned nloc = b.st[0], nx = b.st[1];
        if (nloc == 0u) { xcd_barrier_complete(bar, b.x, nloc, nx); b.st[0] = nloc; b.st[1] = nx; }
        const unsigned old = xb_add(&bar[XB_XSUB(b.x)], 1u);
        const unsigned gen = old / nloc;
        if (old + 1u == (gen + 1u) * nloc) {
            __builtin_amdgcn_fence(__ATOMIC_RELEASE, "agent");
            asm volatile("s_waitcnt vmcnt(0)" ::: "memory");
            const unsigned og = xb_add(&bar[XB_TOP], 1u);
            const unsigned tg = og / nx;
            if (og + 1u == (tg + 1u) * nx) xb_add(&bar[XB_TOPGEN], 1u);
            else XB_SPIN(xb_ld(&bar[XB_TOPGEN]) == tg, bar);
            __builtin_amdgcn_fence(__ATOMIC_ACQUIRE, "agent");
            xb_add(&bar[XB_XGEN(b.x)], 1u);
            asm volatile("s_waitcnt vmcnt(0)" ::: "memory");
        } else {
            XB_SPIN(xb_ld(&bar[XB_XGEN(b.x)]) == gen, bar);
            __builtin_amdgcn_fence(__ATOMIC_ACQUIRE, "agent");
            asm volatile("s_waitcnt vmcnt(0)" ::: "memory");
        }
    }
    __syncthreads();
}


#ifndef REP_NA
#define REP_NA 1
#endif
#ifndef REP_F
#define REP_F 1
#endif
#ifndef REP_L
#define REP_L 1
#endif
#ifndef REP_N
#define REP_N 1
#endif
#ifndef REP_G1
#define REP_G1 1
#endif
#ifndef REP_G3
#define REP_G3 1
#endif
#ifndef REP_S
#define REP_S 1
#endif
__global__ void __launch_bounds__(NTHR, 2) fwd_megakernel(Args a) {
    extern __shared__ __attribute__((aligned(16))) unsigned char lds_raw[];
    LAS unsigned char* lds = (LAS unsigned char*)lds_raw;
    cg::grid_group grid = cg::this_grid();
    const int G = gridDim.x;
#define GRID_SYNC_CG() do { asm volatile("s_waitcnt vmcnt(0) lgkmcnt(0)" ::: "memory"); grid.sync(); __builtin_amdgcn_fence(__ATOMIC_ACQUIRE, "agent"); asm volatile("s_waitcnt vmcnt(0)" ::: "memory"); } while (0)
#define GRID_SYNC() do { for (int rs_ = 0; rs_ < REP_S; ++rs_) xcd_barrier(xbar); } while (0)
#define FRESH() int t_ = threadIdx.x; asm volatile("" : "+v"(t_)); const int tid = t_, lane = tid & 63, wave = __builtin_amdgcn_readfirstlane(tid >> 6); (void)lane; (void)wave;
    unsigned char* ws = a.ws;
    bf16* const Hb = (bf16*)(ws + WS_H); bf16* const Pb = (bf16*)(ws + WS_P); bf16* const Yb = (bf16*)(ws + WS_Y); bf16* const HIDb = (bf16*)(ws + WS_HID);
    bf16* const Z2 = (bf16*)(ws + WS_H);
    float* const out = a.out;
    volatile LAS unsigned* xst = (volatile LAS unsigned*)(lds + LDS_BYTES - 16);
    if (threadIdx.x < 4) xst[threadIdx.x] = 0u;
    __syncthreads();
    const XcdBarrier xbar = xcd_barrier_post((unsigned*)(ws + WS_BAR), xst);

#ifndef REP_PA
#define REP_PA 1
#endif
    for (int rep = 0; rep < REP_PA; ++rep) { FRESH(); phase_prologue_a(a, lds, tid, wave, lane, G); __syncthreads(); }
    GRID_SYNC_CG();
    { FRESH(); phase_prologue_b(a, tid, G); }
    GRID_SYNC();

    { FRESH(); phase_xt0(a.in[0], a.in[4], (const float*)(ws + WS_MOD), 1024, Hb, (float*)(ws + WS_SS), wave, lane, G); phase_bias(ws, wave, lane, G); }
    GRID_SYNC();
    float* const SSb = (float*)(ws + WS_SS);
    bf16* const XBb = (bf16*)(ws + WS_XB);
    for (int l = 0; l < DEPTH; ++l) {
        const float* modl = (const float*)(ws + WS_MOD) + (size_t)l * NBATCH * 6144;
        for (int rep = 0; rep < REP_G1; ++rep) { pg8::Gemm g{Hb, (const bf16*)(ws + WS_WIN) + (size_t)l * DINP * DM, T, DINP, DM}; pg8::StaticOrder S; S.init(T, DINP, G, (int)blockIdx.x);
          pg8::EpiP E{Pb, DINP, SSb, (const float*)(ws + WS_BIN) + (size_t)l * NBATCH * DINP, DINP};
          pg8::gemm_phase<pg8::EpiP, pg8::StaticOrder, true, true>(lds, g, S, E); }
        GRID_SYNC();
        LruPtrs lp{Pb, (const bf16*)(ws + WS_WLRU), a.in[8], a.in[9], a.in[11], a.in[13], a.in[14], (float*)(ws + WS_CAR), (const float*)(ws + WS_HIN), Yb, nullptr};
        for (int rep = 0; rep < REP_L; ++rep) { FRESH(); lru_phase<1>(lds, lp, l, tid, wave, lane, G); }
        GRID_SYNC();
        { FRESH(); lru_carry_scan((const float*)(ws + WS_CAR), (float*)(ws + WS_HIN), tid); }
        for (int rep = 0; rep < REP_F; ++rep) { FRESH(); build_dft_tables(lds, tid); __syncthreads();
          { int it = blockIdx.x; u32x4 cur = fourier1_load(Pb, it < NBATCH * 4 * 64 ? it : 0, tid);
            for (; it < NBATCH * 4 * 64; it += G) { u32x4 nxt = cur; if (it + G < NBATCH * 4 * 64) nxt = fourier1_load(Pb, it + G, tid);
                fourier1_item(lds, cur, Z2, it, tid, wave, lane, nullptr); cur = nxt; } }
          __syncthreads(); }
        for (int rep = 0; rep < REP_NA; ++rep) { FRESH(); na_phase(lds, Pb, a.in[15] + (size_t)l * 6 * 465, Yb, tid, wave, lane, G); }
        GRID_SYNC();
        for (int rep = 0; rep < REP_F; ++rep) { FRESH(); build_dft_tables(lds, tid); __syncthreads();
          { const bf16* WFl = (const bf16*)(ws + WS_WF) + (size_t)l * 4 * 4096; int it = blockIdx.x; F2Pre cur = fourier2_load(Z2, WFl, it < NBATCH * 4 * 64 ? it : 0, tid);
            for (; it < NBATCH * 4 * 64; it += G) { F2Pre nxt = cur; if (it + G < NBATCH * 4 * 64) nxt = fourier2_load(Z2, WFl, it + G, tid);
                fourier2_item(lds, cur, Yb, it, tid, wave, lane, nullptr); cur = nxt; } }
          __syncthreads(); }
        for (int rep = 0; rep < REP_L; ++rep) { FRESH(); lru_phase<2>(lds, lp, l, tid, wave, lane, G); }
        GRID_SYNC();
        { pg8::Gemm g{Yb, (const bf16*)(ws + WS_WOUT) + (size_t)l * DM * DM, T, DM, DM}; pg8::StaticOrder S; S.init(T, DM, G, (int)blockIdx.x);
          pg8::EpiRes E{l == 0 ? a.in[0] : nullptr, l == 0 ? nullptr : XBb, XBb, modl + 2048, a.in[5] + l * DM, modl + 4096, Hb, SSb};
          pg8::gemm_phase<pg8::EpiRes, pg8::StaticOrder, true, true>(lds, g, S, E); }
        GRID_SYNC();
        for (int rep = 0; rep < REP_G3; ++rep) { pg8::Gemm g{Hb, (const bf16*)(ws + WS_WGU) + (size_t)l * 5632 * DM, T, 5632, DM}; pg8::StaticOrder S; S.init(T, 5632, G, (int)blockIdx.x);
          pg8::EpiSwiGLU E{HIDb, SSb, (const float*)(ws + WS_BGU) + (size_t)l * NBATCH * 5632};
          pg8::gemm_phase<pg8::EpiSwiGLU, pg8::StaticOrder, true, true>(lds, g, S, E); }
        GRID_SYNC();
        { pg8::Gemm g{HIDb, (const bf16*)(ws + WS_WDN) + (size_t)l * DM * DFF, T, DM, DFF}; pg8::StaticOrder S; S.init(T, DM, G, (int)blockIdx.x);
          const bool more = (l + 1 < DEPTH);
          pg8::EpiRes E{nullptr, XBb, XBb, modl + 5120, more ? a.in[4] + (l + 1) * DM : nullptr, more ? modl + NBATCH * 6144 + 1024 : modl, Hb, SSb};
          pg8::gemm_phase<pg8::EpiRes, pg8::StaticOrder, true, true>(lds, g, S, E); }
        GRID_SYNC();
    }
    { FRESH(); phase_final_norm(XBb, out, a.in[20], wave, lane, G); }
}

extern "C" void kernel_launch(void* const* d_in, const int* in_sizes, int n_in, void* d_out, int out_size, void* d_ws, size_t ws_size, hipStream_t stream) {
    static int grid_blocks = 0;
    if (grid_blocks == 0) {
        if (n_in != 21 || out_size != T * DM || ws_size < WS_END) { fprintf(stderr, "kernel_launch: unexpected problem (n_in %d, out %d, ws %zu)\n", n_in, out_size, ws_size); grid_blocks = -1; return; }
        int dev = 0, cus = 0, per_cu = 0;
        hipGetDevice(&dev);
        hipDeviceGetAttribute(&cus, hipDeviceAttributeMultiprocessorCount, dev);
        if (hipFuncSetAttribute((const void*)fwd_megakernel, hipFuncAttributeMaxDynamicSharedMemorySize, LDS_BYTES) != hipSuccess) { fprintf(stderr, "kernel_launch: hipFuncSetAttribute failed\n"); grid_blocks = -1; return; }
        if (hipOccupancyMaxActiveBlocksPerMultiprocessor(&per_cu, (const void*)fwd_megakernel, NTHR, LDS_BYTES) != hipSuccess || per_cu < 1) { fprintf(stderr, "kernel_launch: occupancy query failed (%d)\n", per_cu); per_cu = 1; (void)hipGetLastError(); }
        grid_blocks = cus * per_cu;
    }
    if (grid_blocks < 0) return;
    Args a{};
    for (int i = 0; i < 21; ++i) a.in[i] = (const float*)d_in[i];
    a.out = (float*)d_out; a.ws = (unsigned char*)d_ws;
    if (hipMemsetAsync((unsigned char*)d_ws + WS_BAR, 0, XCD_BAR_WORDS * 4, stream) != hipSuccess) { fprintf(stderr, "kernel_launch: memset of the barrier words failed\n"); return; }
    void* args[] = {&a};
    hipError_t e = hipLaunchCooperativeKernel((const void*)fwd_megakernel, dim3(grid_blocks), dim3(NTHR), args, LDS_BYTES, stream);
    if (e != hipSuccess) fprintf(stderr, "cooperative launch failed: %s (grid %d)\n", hipGetErrorString(e), grid_blocks);
}
```

```cpp
#include <hip/hip_runtime.h>
#include <hip/hip_cooperative_groups.h>
#include <cstdio>
#include <cstdint>
namespace cg = cooperative_groups;
namespace pg8 {
#define PG8_LAS __attribute__((address_space(3)))
typedef unsigned short bf16_t;
typedef short bf16x8 __attribute__((ext_vector_type(8)));
typedef float f32x4 __attribute__((ext_vector_type(4)));
typedef unsigned u32x4 __attribute__((ext_vector_type(4)));
typedef unsigned u32x2 __attribute__((ext_vector_type(2)));
constexpr int BM = 256, BK = 64, HALF = 128, HTB = HALF * BK * 2  , STAGE_BYTES = 8 * HTB, NXCD = 8, WGM = 8;

__host__ __device__ __forceinline__ int lds_byte(int r, int c) { const int st = (r >> 4) * 2 + (c >> 5), rr = r & 15, cc = c & 31, ob = rr * 64 + cc * 2; return st * 1024 + (ob ^ (((ob >> 9) & 1) << 5)); }
__host__ __device__ __forceinline__ void stage_rc(int b, int& R, int& C) { const int st = b / 1024, sb = b % 1024, swz = sb ^ (((sb >> 9) & 1) << 5); R = (st >> 1) * 16 + swz / 64; C = (st & 1) * 32 + (swz % 64) / 2; }
__host__ __device__ __forceinline__ int perm32(int rho) { const int n = rho >> 4, i = rho & 15; return 8 * (i >> 2) + 4 * n + (i & 3); }

struct Unit { int pm, pn; };
struct Gemm { const bf16_t* A; const bf16_t* Bt; int M, N, K; };

struct StaticOrder {
    int nM, nN, nwg, G, c;
    __host__ __device__ void init(int M, int N, int G_, int c_) { nM = M / BM; nN = N / BM; nwg = nM * nN; G = G_; c = c_; }
    __host__ __device__ bool next(int i, Unit& u) const {
        const long L = (long)i * G + c; if (L >= nwg) return false;
        int wgid = (int)L; { const int q = nwg / NXCD, r = nwg % NXCD, xcd = wgid % NXCD, off = wgid / NXCD; wgid = (xcd < r ? xcd * (q + 1) : r * (q + 1) + (xcd - r) * q) + off; }
        const int nig = WGM * nN, gid = wgid / nig, fm = gid * WGM, gsz = (nM - fm) < WGM ? (nM - fm) : WGM;
        u.pm = fm + ((wgid % nig) % gsz); u.pn = (wgid % nig) / gsz; return true;
    }
    __device__ __forceinline__ void a_ready(const Unit&) const {}
    __device__ __forceinline__ void done(const Unit&) const {}
};

typedef float cvt_f32x2 __attribute__((ext_vector_type(2)));
typedef __bf16 cvt_bf16x2 __attribute__((ext_vector_type(2)));
__device__ __forceinline__ unsigned cvt_pk_bf16(float lo, float hi) { const cvt_f32x2 v = {lo, hi}; const cvt_bf16x2 b = __builtin_convertvector(v, cvt_bf16x2); return __builtin_bit_cast(unsigned, b); }

#ifdef DBG_FLAGS
#define PG_CHK(dbgp, v, bit) do {} while (0)
#else
#define PG_CHK(dbgp, v, bit) do {} while (0)
#endif
__device__ __forceinline__ float row_rstd(const float* SS, int row, int fq) {
    const f32x4 v = *(const f32x4*)(SS + (size_t)row * 16 + 4 * fq);
    float s = (v[0] + v[1]) + (v[2] + v[3]);
    s += __shfl_xor(s, 16); s += __shfl_xor(s, 32);
    return rsqrtf(s * (1.0f / 1024.0f) + 1e-6f);
}
struct EpiP {
    static constexpr bool PERM = true, AFTER_DRAIN = false;
    bf16_t* O; int ldc; const float* SS; const float* bias; int bias_ld;
    __device__ __forceinline__ void operator()(const f32x4 (&acc)[2][2][4][2], const Unit& u, int wr, int wc, int fr, int fq) const {
        const int row0 = u.pm * BM + wr * 64 + fr, col0 = u.pn * BM + wc * 32 + 8 * fq;
        const float* bp = bias + (size_t)(u.pm >> 4) * bias_ld + col0;
        f32x4 bv[2][2];
#pragma unroll
        for (int bj = 0; bj < 2; ++bj)
#pragma unroll
            for (int n = 0; n < 2; ++n) bv[bj][n] = *(const f32x4*)(bp + bj * HALF + 4 * n);
        float rsv[2][4];
        { f32x4 sv[2][4];
#pragma unroll
          for (int ai = 0; ai < 2; ++ai)
#pragma unroll
              for (int m = 0; m < 4; ++m) sv[ai][m] = *(const f32x4*)(SS + (size_t)(row0 + ai * HALF + m * 16) * 16 + 4 * fq);
          __builtin_amdgcn_sched_barrier(0);
#pragma unroll
          for (int ai = 0; ai < 2; ++ai)
#pragma unroll
              for (int m = 0; m < 4; ++m) { float t = (sv[ai][m][0] + sv[ai][m][1]) + (sv[ai][m][2] + sv[ai][m][3]); t += __shfl_xor(t, 16); t += __shfl_xor(t, 32); rsv[ai][m] = rsqrtf(t * (1.0f / 1024.0f) + 1e-6f); } }
#pragma unroll
        for (int ai = 0; ai < 2; ++ai)
#pragma unroll
            for (int m = 0; m < 4; ++m) { const int row = row0 + ai * HALF + m * 16; const float rs = rsv[ai][m];
                bf16_t* rowp = O + (size_t)row * ldc + col0;
#pragma unroll
                for (int bj = 0; bj < 2; ++bj) { const f32x4 v0 = acc[ai][bj][m][0] * rs + bv[bj][0], v1 = acc[ai][bj][m][1] * rs + bv[bj][1];
                    u32x4 w; w.x = cvt_pk_bf16(v0[0], v0[1]); w.y = cvt_pk_bf16(v0[2], v0[3]); w.z = cvt_pk_bf16(v1[0], v1[1]); w.w = cvt_pk_bf16(v1[2], v1[3]);
                    *(u32x4*)(rowp + bj * HALF) = w; } }
    }
};
struct EpiRes {
    static constexpr bool PERM = true, AFTER_DRAIN = false;
    const float* xin32; const bf16_t* xin16; bf16_t* xout; const float* gate; const float* gmul; const float* gsc; bf16_t* Hn; float* SS;
    __device__ __forceinline__ void operator()(const f32x4 (&acc)[2][2][4][2], const Unit& u, int wr, int wc, int fr, int fq) const {
        const int row0 = u.pm * BM + wr * 64 + fr, col0 = u.pn * BM + wc * 32 + 8 * fq;
        const float* gp = gate + (size_t)(u.pm >> 4) * 6144 + col0;
        const float* sp_ = gsc + (size_t)(u.pm >> 4) * 6144 + col0;
        const bool emit = gmul != nullptr, in16 = xin16 != nullptr;
        f32x4 gv[2][2], gm[2][2];
#pragma unroll
        for (int bj = 0; bj < 2; ++bj)
#pragma unroll
            for (int n = 0; n < 2; ++n) { const int co = bj * HALF + 4 * n; gv[bj][n] = *(const f32x4*)(gp + co);
                gm[bj][n] = emit ? *(const f32x4*)(gmul + col0 + co) * (*(const f32x4*)(sp_ + co) + 1.0f) : (f32x4){0.f, 0.f, 0.f, 0.f}; }
        u32x4 xb[2][2];
        if (in16) {
#pragma unroll
            for (int bj = 0; bj < 2; ++bj) xb[0][bj] = *(const u32x4*)(xin16 + (size_t)row0 * 1024 + col0 + bj * HALF); }
#pragma unroll
        for (int it = 0; it < 8; ++it) { const int ai = it >> 2, m = it & 3, row = row0 + ai * HALF + m * 16; const size_t off = (size_t)row * 1024 + col0;
            f32x4 xf[2][2];
            if (in16) {
                if (it < 7) { const size_t offn = (size_t)(row0 + ((it + 1) >> 2) * HALF + ((it + 1) & 3) * 16) * 1024 + col0;
#pragma unroll
                    for (int bj = 0; bj < 2; ++bj) xb[(it + 1) & 1][bj] = *(const u32x4*)(xin16 + offn + bj * HALF); }
#pragma unroll
                for (int bj = 0; bj < 2; ++bj) { const u32x4 w = xb[it & 1][bj];
                    xf[bj][0] = (f32x4){__builtin_bit_cast(float, w.x << 16), __builtin_bit_cast(float, w.x & 0xffff0000u), __builtin_bit_cast(float, w.y << 16), __builtin_bit_cast(float, w.y & 0xffff0000u)};
                    xf[bj][1] = (f32x4){__builtin_bit_cast(float, w.z << 16), __builtin_bit_cast(float, w.z & 0xffff0000u), __builtin_bit_cast(float, w.w << 16), __builtin_bit_cast(float, w.w & 0xffff0000u)}; }
            } else {
#pragma unroll
                for (int bj = 0; bj < 2; ++bj)
#pragma unroll
                    for (int n = 0; n < 2; ++n) xf[bj][n] = *(const f32x4*)(xin32 + off + bj * HALF + 4 * n);
            }
            float ss = 0.f;
#pragma unroll
            for (int bj = 0; bj < 2; ++bj) { const f32x4 x0 = xf[bj][0] + gv[bj][0] * acc[ai][bj][m][0], x1 = xf[bj][1] + gv[bj][1] * acc[ai][bj][m][1];
                u32x4 w; w.x = cvt_pk_bf16(x0[0], x0[1]); w.y = cvt_pk_bf16(x0[2], x0[3]); w.z = cvt_pk_bf16(x1[0], x1[1]); w.w = cvt_pk_bf16(x1[2], x1[3]);
                *(u32x4*)(xout + off + bj * HALF) = w;
                if (emit) { const f32x4 h0 = x0 * gm[bj][0], h1 = x1 * gm[bj][1];
                    ss += ((x0[0] * x0[0] + x0[1] * x0[1]) + (x0[2] * x0[2] + x0[3] * x0[3])) + ((x1[0] * x1[0] + x1[1] * x1[1]) + (x1[2] * x1[2] + x1[3] * x1[3]));
                    u32x4 hw; hw.x = cvt_pk_bf16(h0[0], h0[1]); hw.y = cvt_pk_bf16(h0[2], h0[3]); hw.z = cvt_pk_bf16(h1[0], h1[1]); hw.w = cvt_pk_bf16(h1[2], h1[3]);
                    *(u32x4*)(Hn + off + bj * HALF) = hw; } }
            if (emit) { ss += __shfl_xor(ss, 16); ss += __shfl_xor(ss, 32); if (fq == 0) SS[(size_t)row * 16 + u.pn * 4 + wc] = ss; }
            __builtin_amdgcn_sched_barrier(0); }
    }
};
struct EpiSwiGLU {
    static constexpr bool PERM = true, AFTER_DRAIN = false;
    bf16_t* O; const float* SS; const float* bias;
    __device__ __forceinline__ void operator()(const f32x4 (&acc)[2][2][4][2], const Unit& u, int wr, int wc, int fr, int fq) const {
        const int row0 = u.pm * BM + wr * 64 + fr, col0 = u.pn * HALF + wc * 32 + 8 * fq;
        const float* bp = bias + (size_t)(u.pm >> 4) * 5632 + u.pn * BM + wc * 32 + 8 * fq;
        f32x4 bv[2][2];
#pragma unroll
        for (int bj = 0; bj < 2; ++bj)
#pragma unroll
            for (int n = 0; n < 2; ++n) bv[bj][n] = *(const f32x4*)(bp + bj * HALF + 4 * n);
        float rsv[2][4];
        { f32x4 sv[2][4];
#pragma unroll
          for (int ai = 0; ai < 2; ++ai)
#pragma unroll
              for (int m = 0; m < 4; ++m) sv[ai][m] = *(const f32x4*)(SS + (size_t)(row0 + ai * HALF + m * 16) * 16 + 4 * fq);
          __builtin_amdgcn_sched_barrier(0);
#pragma unroll
          for (int ai = 0; ai < 2; ++ai)
#pragma unroll
              for (int m = 0; m < 4; ++m) { float t = (sv[ai][m][0] + sv[ai][m][1]) + (sv[ai][m][2] + sv[ai][m][3]); t += __shfl_xor(t, 16); t += __shfl_xor(t, 32); rsv[ai][m] = rsqrtf(t * (1.0f / 1024.0f) + 1e-6f); } }
#pragma unroll
        for (int ai = 0; ai < 2; ++ai)
#pragma unroll
            for (int m = 0; m < 4; ++m) { const int row = row0 + ai * HALF + m * 16; const float rs = rsv[ai][m];
                bf16_t* rowp = O + (size_t)row * 2816 + col0;
                float r[8];
#pragma unroll
                for (int n = 0; n < 2; ++n)
#pragma unroll
                    for (int j = 0; j < 4; ++j) { const float g = acc[ai][0][m][n][j] * rs + bv[0][n][j], up = acc[ai][1][m][n][j] * rs + bv[1][n][j];
                        r[4 * n + j] = g * __builtin_amdgcn_rcpf(1.0f + __expf(-g)) * up; }
                u32x4 w; w.x = cvt_pk_bf16(r[0], r[1]); w.y = cvt_pk_bf16(r[2], r[3]); w.z = cvt_pk_bf16(r[4], r[5]); w.w = cvt_pk_bf16(r[6], r[7]);
                *(u32x4*)rowp = w; }
    }
};
template <class Epi, class Sched, bool ALIGN_EPI = false, bool SP2 = false>
__device__ __forceinline__ void gemm_phase(PG8_LAS unsigned char* lds, const Gemm g, const Sched& S, const Epi& E) {
    int tid_ = threadIdx.x; asm volatile("" : "+v"(tid_));
    const int tid = tid_, wid = __builtin_amdgcn_readfirstlane(tid >> 6), lane = tid & 63, wr = wid >> 2, wc = wid & 3, fr = lane & 15, fq = lane >> 4;
    const int K = g.K, nt = K / BK;
    unsigned voffA[2], voffB[2];
#pragma unroll
    for (int i = 0; i < 2; ++i) { int R, C; stage_rc(tid * 16 + i * 8192, R, C); const int Rb = Epi::PERM ? ((R & ~31) + perm32(R & 31)) : R;
        voffA[i] = (unsigned)(R * K + C) * 2u; voffB[i] = (unsigned)(Rb * K + C) * 2u; }
    const size_t kstep = (size_t)(BK * 2);
    const size_t hstep = (size_t)HALF * K * 2;
    const size_t tstep = 2 * hstep;
    const unsigned ldsw = (unsigned)wid * 1024u;
    const int aoff = lds_byte(wr * 64 + fr, fq * 8), boff = lds_byte(wc * 32 + fr, fq * 8);
#define PG8_SA(b, h) (((b) * 2 + (h)) * HTB)
#define PG8_SB(b, h) ((4 + (b) * 2 + (h)) * HTB)
#define PG8_STAGE(bufoff, gbase, voff) do { _Pragma("unroll") for (int _i = 0; _i < 2; ++_i) \
        __builtin_amdgcn_global_load_lds((const unsigned*)((const char*)(gbase) + (voff)[_i]), (PG8_LAS unsigned*)(lds + (bufoff) + ldsw + _i * 8192), 16, 0, 0); } while (0)
#define PG8_LDA(dst, b, h) do { _Pragma("unroll") for (int m = 0; m < 4; ++m) _Pragma("unroll") for (int k = 0; k < 2; ++k) dst[m][k] = *(const PG8_LAS bf16x8*)(lds + PG8_SA(b, h) + aoff + m * 2048 + k * 1024); } while (0)
#define PG8_LDB(dst, b, h) do { _Pragma("unroll") for (int n = 0; n < 2; ++n) _Pragma("unroll") for (int k = 0; k < 2; ++k) dst[n][k] = *(const PG8_LAS bf16x8*)(lds + PG8_SB(b, h) + boff + n * 2048 + k * 1024); } while (0)
#define PG8_MMA(ai, bj, At, Bt) do { __builtin_amdgcn_s_setprio(1); _Pragma("unroll") for (int m = 0; m < 4; ++m) _Pragma("unroll") for (int n = 0; n < 2; ++n) _Pragma("unroll") for (int k = 0; k < 2; ++k) \
        acc[ai][bj][m][n] = __builtin_amdgcn_mfma_f32_16x16x32_bf16(Bt[n][k], At[m][k], acc[ai][bj][m][n], 0, 0, 0); __builtin_amdgcn_s_setprio(0); } while (0)
#define PG8_WAIT_V(n) asm volatile("s_waitcnt vmcnt(" #n ")" ::: "memory")
#define PG8_WAIT_L(n) asm volatile("s_waitcnt lgkmcnt(" #n ")" ::: "memory")
#define PG8_BAR __builtin_amdgcn_s_barrier()
#define PG8_SCHED __builtin_amdgcn_sched_barrier(0)
    Unit cur, nxt; int ui = 0;
    if (!S.next(0, cur)) return;
    f32x4 acc[2][2][4][2];
#pragma unroll
    for (int a = 0; a < 2; ++a)
#pragma unroll
        for (int b = 0; b < 2; ++b)
#pragma unroll
            for (int m = 0; m < 4; ++m)
#pragma unroll
                for (int n = 0; n < 2; ++n) acc[a][b][m][n] = (f32x4){0.f, 0.f, 0.f, 0.f};
    bf16x8 At[4][2], B0[2][2], B1[2][2];
    const char* cA = (const char*)g.A + (size_t)cur.pm * tstep; const char* cB = (const char*)g.Bt + (size_t)cur.pn * tstep;
    S.a_ready(cur);
    if constexpr (SP2) {
        PG8_STAGE(PG8_SB(0, 0), cB, voffB); PG8_STAGE(PG8_SB(0, 1), cB + hstep, voffB); PG8_STAGE(PG8_SA(0, 0), cA, voffA); PG8_STAGE(PG8_SA(0, 1), cA + hstep, voffA);
        if (wr == 1) PG8_BAR;
        PG8_WAIT_V(2); PG8_BAR;
        PG8_STAGE(PG8_SB(1, 0), cB + kstep, voffB); PG8_STAGE(PG8_SA(1, 0), cA + kstep, voffA); PG8_STAGE(PG8_SB(1, 1), cB + hstep + kstep, voffB);
        PG8_WAIT_V(6); PG8_BAR;
    } else {
        PG8_STAGE(PG8_SB(0, 0), cB, voffB); PG8_STAGE(PG8_SA(0, 0), cA, voffA); PG8_STAGE(PG8_SB(0, 1), cB + hstep, voffB); PG8_STAGE(PG8_SA(0, 1), cA + hstep, voffA);
        if (wr == 1) PG8_BAR;
        PG8_WAIT_V(4); PG8_BAR;
        PG8_STAGE(PG8_SB(1, 0), cB + kstep, voffB); PG8_STAGE(PG8_SA(1, 0), cA + kstep, voffA); PG8_STAGE(PG8_SB(1, 1), cB + hstep + kstep, voffB);
        PG8_WAIT_V(6); PG8_BAR;
    }
    for (;;) {
        const bool has_next = S.next(ui + 1, nxt);
        const char* nA = has_next ? (const char*)g.A + (size_t)nxt.pm * tstep : cA; const char* nB = has_next ? (const char*)g.Bt + (size_t)nxt.pn * tstep : cB;
        for (int t = 0; t < nt; t += 2) {
            const bool last = (t == nt - 2);
            const char* a1 = cA + (size_t)(t + 1) * kstep;
            const char* a2 = last ? nA : cA + (size_t)(t + 2) * kstep; const char* b2 = last ? nB : cB + (size_t)(t + 2) * kstep;
            const char* a3 = a2 + kstep; const char* b3 = b2 + kstep;
            if (last && has_next) S.a_ready(nxt);
            if constexpr (SP2) {
            PG8_LDB(B0, 0, 0); PG8_LDB(B1, 0, 1); PG8_SCHED; PG8_LDA(At, 0, 0); PG8_STAGE(PG8_SA(1, 1), a1 + hstep, voffA);
            PG8_WAIT_V(8); PG8_WAIT_L(0); PG8_BAR; PG8_MMA(0, 0, At, B0); PG8_MMA(0, 1, At, B1); PG8_BAR; PG8_SCHED;
            PG8_LDA(At, 0, 1); PG8_STAGE(PG8_SB(0, 0), b2, voffB); PG8_STAGE(PG8_SB(0, 1), b2 + hstep, voffB); PG8_STAGE(PG8_SA(0, 0), a2, voffA);
            PG8_WAIT_V(8); PG8_WAIT_L(0); PG8_BAR; PG8_MMA(1, 0, At, B0); PG8_MMA(1, 1, At, B1); PG8_BAR; PG8_SCHED;
            PG8_LDB(B0, 1, 0); PG8_LDB(B1, 1, 1); PG8_SCHED; PG8_LDA(At, 1, 0); PG8_STAGE(PG8_SA(0, 1), a2 + hstep, voffA);
            PG8_WAIT_V(8); PG8_WAIT_L(0); PG8_BAR; PG8_MMA(0, 0, At, B0); PG8_MMA(0, 1, At, B1); PG8_BAR; PG8_SCHED;
            PG8_LDA(At, 1, 1); PG8_STAGE(PG8_SB(1, 0), b3, voffB); PG8_STAGE(PG8_SB(1, 1), b3 + hstep, voffB); PG8_STAGE(PG8_SA(1, 0), a3, voffA);
            PG8_WAIT_V(8); PG8_WAIT_L(0); PG8_BAR; PG8_MMA(1, 0, At, B0); PG8_MMA(1, 1, At, B1); PG8_BAR; PG8_SCHED;
            } else {
            PG8_LDB(B0, 0, 0); PG8_SCHED; PG8_LDA(At, 0, 0); PG8_STAGE(PG8_SA(1, 1), a1 + hstep, voffA);
            PG8_WAIT_L(8); PG8_BAR; PG8_WAIT_L(0); PG8_MMA(0, 0, At, B0); PG8_BAR; PG8_SCHED;
            PG8_LDB(B1, 0, 1); PG8_STAGE(PG8_SB(0, 0), b2, voffB);
            PG8_BAR; PG8_WAIT_L(0); PG8_MMA(0, 1, At, B1); PG8_BAR;
            PG8_LDA(At, 0, 1); PG8_STAGE(PG8_SA(0, 0), a2, voffA);
            PG8_BAR; PG8_WAIT_L(0); PG8_MMA(1, 0, At, B0); PG8_BAR; PG8_SCHED;
            PG8_STAGE(PG8_SB(0, 1), b2 + hstep, voffB);
            PG8_WAIT_V(6); PG8_BAR; PG8_MMA(1, 1, At, B1); PG8_BAR;
            PG8_LDB(B0, 1, 0); PG8_SCHED; PG8_LDA(At, 1, 0); PG8_STAGE(PG8_SA(0, 1), a2 + hstep, voffA);
            PG8_WAIT_L(8); PG8_BAR; PG8_WAIT_L(0); PG8_MMA(0, 0, At, B0); PG8_BAR; PG8_SCHED;
            PG8_LDB(B1, 1, 1); PG8_STAGE(PG8_SB(1, 0), b3, voffB);
            PG8_BAR; PG8_WAIT_L(0); PG8_MMA(0, 1, At, B1); PG8_BAR;
            PG8_LDA(At, 1, 1); PG8_STAGE(PG8_SA(1, 0), a3, voffA);
            PG8_BAR; PG8_WAIT_L(0); PG8_MMA(1, 0, At, B0); PG8_BAR; PG8_SCHED;
            PG8_STAGE(PG8_SB(1, 1), b3 + hstep, voffB);
            PG8_WAIT_V(6); PG8_BAR; PG8_MMA(1, 1, At, B1); PG8_BAR;
            }
        }
        if constexpr (ALIGN_EPI) { if (wr == 0) PG8_BAR; }
        if constexpr (!Epi::AFTER_DRAIN) { E(acc, cur, wr, wc, fr, fq); S.done(cur); }
        if (!has_next) break;
#pragma unroll
        for (int a = 0; a < 2; ++a)
#pragma unroll
            for (int b = 0; b < 2; ++b)
#pragma unroll
                for (int m = 0; m < 4; ++m)
#pragma unroll
                    for (int n = 0; n < 2; ++n) acc[a][b][m][n] = (f32x4){0.f, 0.f, 0.f, 0.f};
        cur = nxt; cA = nA; cB = nB; ++ui;
        if constexpr (ALIGN_EPI) { if (wr == 1) PG8_BAR; }
    }
    PG8_WAIT_V(0);
    if constexpr (!ALIGN_EPI) { if (wr == 0) PG8_BAR; }
    PG8_BAR;
    if constexpr (Epi::AFTER_DRAIN) { E.fused(acc, cur, wr, wc, fr, fq, lds, wid, lane); S.done(cur); }
#undef PG8_SA
#undef PG8_SB
#undef PG8_STAGE
#undef PG8_LDA
#undef PG8_LDB
#undef PG8_MMA
#undef PG8_WAIT_V
#undef PG8_WAIT_L
#undef PG8_BAR
#undef PG8_SCHED
}
}


#define LAS __attribute__((address_space(3)))
typedef unsigned short bf16;
typedef float f32x4 __attribute__((ext_vector_type(4)));
typedef short bf16x8 __attribute__((ext_vector_type(8)));
typedef unsigned u32x4 __attribute__((ext_vector_type(4)));
typedef unsigned u32x2 __attribute__((ext_vector_type(2)));

constexpr int T = 65536, DM = 1024, SEQ = 4096, NBATCH = 16, DIN = 2176, DINP = 2304, DFF = 2816, DEPTH = 4, DLRU = 384;
constexpr int NTHR = 512, NWAVES = 8;
constexpr int LDS_BYTES = 155648;
constexpr size_t MiB = 1u << 20;
constexpr size_t WS_WIN = 0;
constexpr size_t WS_WOUT = 18 * MiB;
constexpr size_t WS_WGU = 26 * MiB;
constexpr size_t WS_WDN = 70 * MiB;
constexpr size_t WS_WLRU = 92 * MiB;
constexpr size_t WS_WF = 93 * MiB;
constexpr size_t WS_MOD = 94 * MiB;
constexpr size_t WS_MODP = 96 * MiB;
constexpr size_t WS_CAR = 122 * MiB;
constexpr size_t WS_HIN = 128 * MiB;
constexpr size_t WS_H = 132 * MiB;
constexpr size_t WS_P = 260 * MiB;
constexpr size_t WS_Y = 548 * MiB;
constexpr size_t WS_HID = 260 * MiB;
constexpr size_t WS_BAR = 131 * MiB;
constexpr size_t WS_SS = 676 * MiB;
constexpr size_t WS_BIN = 680 * MiB;
constexpr size_t WS_BGU = 681 * MiB;
constexpr size_t WS_XB = 683 * MiB;
constexpr size_t WS_END = 811 * MiB;

struct Args { const float* in[21]; float* out; unsigned char* ws; };
constexpr size_t WS_DBG = 131 * MiB + 512 * 1024;
#ifdef DBG_FLAGS
#define DBG_CHK(dbgp, v, bit) do {} while (0)
#define DBG2(dbgp, v, bit) do { if ((dbgp) && !(fabsf(v) < 1e30f)) atomicOr((dbgp), 1u << (bit)); } while (0)
#else
#define DBG2(dbgp, v, bit) do {} while (0)
#define DBG_CHK(dbgp, v, bit) do {} while (0)
#endif

__device__ __forceinline__ float bflo(unsigned w) { return __uint_as_float(w << 16); }
__device__ __forceinline__ float bfhi(unsigned w) { return __uint_as_float(w & 0xffff0000u); }
__device__ __forceinline__ unsigned pk2(float lo, float hi) { return pg8::cvt_pk_bf16(lo, hi); }
__device__ __forceinline__ u32x2 pk4(f32x4 v) { u32x2 r; r.x = pk2(v[0], v[1]); r.y = pk2(v[2], v[3]); return r; }
__device__ __forceinline__ f32x4 mfma16(bf16x8 a, bf16x8 b, f32x4 c) { return __builtin_amdgcn_mfma_f32_16x16x32_bf16(a, b, c, 0, 0, 0); }
__device__ __forceinline__ float wave_sum(float v) {
#pragma unroll
    for (int o = 1; o < 64; o <<= 1) v += __shfl_xor(v, o);
    return v;
}
__device__ __forceinline__ float sigmoidf_(float x) { return __builtin_amdgcn_rcpf(1.0f + __expf(-x)); }
#define LDS_FRAG(p) (*(const LAS bf16x8*)(p))
#define LDS_BARRIER() do { asm volatile("s_waitcnt lgkmcnt(0)" ::: "memory"); __builtin_amdgcn_s_barrier(); asm volatile("" ::: "memory"); } while (0)

__device__ __forceinline__ void tr_item(const float* W, int K, int N, bf16* WT, int dst_row0, float scale, LAS float* scr, int kb, int nb, int lane) {
    const int k0 = 64 * kb, n0 = 32 * nb;
#pragma unroll 8
    for (int i = 0; i < 32; ++i) { const int kk = 2 * i + (lane >> 5); scr[kk * 33 + (lane & 31)] = W[(size_t)(k0 + kk) * N + n0 + (lane & 31)] * scale; }
    asm volatile("s_waitcnt lgkmcnt(0)" ::: "memory");
    const int c = lane & 7;
#pragma unroll
    for (int j = 0; j < 4; ++j) { const int n = (lane >> 3) + 8 * j; const LAS float* s = scr + (8 * c) * 33 + n;
        u32x4 o; o.x = pk2(s[0 * 33], s[1 * 33]); o.y = pk2(s[2 * 33], s[3 * 33]); o.z = pk2(s[4 * 33], s[5 * 33]); o.w = pk2(s[6 * 33], s[7 * 33]);
        *(u32x4*)(WT + (size_t)(dst_row0 + n) * K + k0 + 8 * c) = o; }
    asm volatile("s_waitcnt lgkmcnt(0)" ::: "memory");
}

__device__ __forceinline__ void phase_prologue_a(const Args& a, LAS unsigned char* lds, int tid, int wave, int lane, int G) {
    unsigned char* ws = a.ws;
    LAS float* cact = (LAS float*)lds;
    for (int i = tid; i < NBATCH * DM; i += NTHR) { const float c = a.in[1][i]; cact[i] = c * sigmoidf_(c); }
    __syncthreads();
    LAS float* scr = (LAS float*)(lds + 65536 + wave * 8448);
    const int gw = blockIdx.x * NWAVES + wave, NGW = G * NWAVES;
    constexpr int I_IN = 16 * 68, I_OUT = 16 * 32, I_G = 16 * 88, I_DN = 44 * 32, I_LRU = 24, I_F = 8;
    constexpr int PER_L = I_IN + I_OUT + 2 * I_G + I_DN + 2 * I_LRU + I_F;
    constexpr int N_TR = DEPTH * PER_L, N_MODP = DEPTH * 24 * 16;
    for (int it = gw; it < N_TR + N_MODP; it += NGW) {
        if (it < N_TR) {
            const int l = it / PER_L; int r = it % PER_L;
            if (r < I_IN) { const int kb = r / 68, nb = r % 68; const float sc = (nb >= 32 && nb < 44) ? 0.125f * 1.4426950408889634f : 1.0f;
                tr_item(a.in[6] + (size_t)l * DM * DIN, DM, DIN, (bf16*)(ws + WS_WIN) + (size_t)l * DINP * DM, 32 * nb, sc, scr, kb, nb, lane); continue; } r -= I_IN;
            if (r < I_OUT) { const int kb = r / 32, nb = r % 32;
                tr_item(a.in[16] + (size_t)l * DM * DM, DM, DM, (bf16*)(ws + WS_WOUT) + (size_t)l * DM * DM, 32 * nb, 1.0f, scr, kb, nb, lane); continue; } r -= I_OUT;
            if (r < 2 * I_G) { const int up = r >= I_G; if (up) r -= I_G; const int kb = r / 88, nb = r % 88; const int n0 = 32 * nb;
                tr_item(a.in[up ? 18 : 17] + (size_t)l * DM * DFF, DM, DFF, (bf16*)(ws + WS_WGU) + (size_t)l * 5632 * DM, 256 * (n0 >> 7) + 128 * up + (n0 & 127), 1.0f, scr, kb, nb, lane); continue; } r -= 2 * I_G;
            if (r < I_DN) { const int kb = r / 32, nb = r % 32;
                tr_item(a.in[19] + (size_t)l * DFF * DM, DFF, DM, (bf16*)(ws + WS_WDN) + (size_t)l * DM * DFF, 32 * nb, 1.0f, scr, kb, nb, lane); continue; } r -= I_DN;
            if (r < 2 * I_LRU) { const int gate = r >= I_LRU; if (gate) r -= I_LRU; const int mat = r >> 1, nb = r & 1;
                const int dir = mat / 6, h = mat % 6;
                tr_item(a.in[gate ? 12 : 10] + (size_t)((l * 2 + dir) * 6 + h) * 4096, 64, 64, (bf16*)(ws + WS_WLRU) + (size_t)((((l * 2 + dir) * 2 + gate) * 6) + h) * 4096, 32 * nb, -1.4426950408889634f, scr, 0, nb, lane); continue; } r -= 2 * I_LRU;
            { const int g = r >> 1, nb = r & 1;
                tr_item(a.in[7] + (size_t)(l * 4 + g) * 4096, 64, 64, (bf16*)(ws + WS_WF) + (size_t)(l * 4 + g) * 4096, 32 * nb, 1.0f, scr, 0, nb, lane); }
        } else {
            const int m = it - N_TR; const int ks = m & 15, cb = (m >> 4) % 24, l = (m >> 4) / 24;
            const int c0 = cb * 256 + lane * 4;
            f32x4 acc[16];
#pragma unroll
            for (int b = 0; b < 16; ++b) acc[b] = (f32x4){0.f, 0.f, 0.f, 0.f};
            const float* wp = a.in[2] + ((size_t)l * DM + ks * 64) * 6144 + c0;
#pragma unroll 4
            for (int kk = 0; kk < 64; ++kk) { const f32x4 w = *(const f32x4*)(wp + (size_t)kk * 6144);
#pragma unroll
                for (int b = 0; b < 16; ++b) { const float ca = cact[b * DM + ks * 64 + kk]; acc[b] += w * ca; } }
            float* mp = (float*)(ws + WS_MODP) + ((size_t)(ks * 64 + l * 16)) * 6144 + c0;
#pragma unroll
            for (int b = 0; b < 16; ++b) *(f32x4*)(mp + (size_t)b * 6144) = acc[b];
        }
    }
    const int gt = blockIdx.x * NTHR + tid, NGT = G * NTHR;
    for (int i = gt; i < DEPTH * 128 * DM / 8; i += NGT) { const int l = i / (128 * DM / 8), o = i % (128 * DM / 8);
        *(u32x4*)((bf16*)(ws + WS_WIN) + (size_t)l * DINP * DM + (size_t)DIN * DM + (size_t)o * 8) = (u32x4){0u, 0u, 0u, 0u}; }
}
__device__ __forceinline__ void phase_prologue_b(const Args& a, int tid, int G) {
    const int gt = blockIdx.x * NTHR + tid, NGT = G * NTHR;
    for (int i = gt; i < DEPTH * NBATCH * 6144 / 4; i += NGT) { const int flat = i * 4, j = flat % 6144, lb = flat / 6144, l = lb >> 4;
        f32x4 s = *(const f32x4*)(a.in[3] + l * 6144 + j);
#pragma unroll
        for (int ks = 0; ks < 16; ++ks) s += *(const f32x4*)((const float*)(a.ws + WS_MODP) + ((size_t)(ks * 64 + lb)) * 6144 + j);
        *(f32x4*)((float*)(a.ws + WS_MOD) + (size_t)lb * 6144 + j) = s; }
}

__device__ __forceinline__ void phase_norm(const float* xin, const float* g, const float* modl, int sh_off, int sc_off, bf16* H, int wave, int lane, int G, unsigned* dbg) {
    const int gw = blockIdx.x * NWAVES + wave, NGW = G * NWAVES;
    for (int m = gw; m < T; m += NGW) {
        const int b = m >> 12;
        const f32x4* xr = (const f32x4*)(xin + (size_t)m * DM) + lane;
        f32x4 v[4]; float ss = 0.f;
#pragma unroll
        for (int j = 0; j < 4; ++j) { v[j] = xr[64 * j]; ss += (v[j][0] * v[j][0] + v[j][1] * v[j][1]) + (v[j][2] * v[j][2] + v[j][3] * v[j][3]); }
        const float rstd = rsqrtf(wave_sum(ss) * (1.0f / DM) + 1e-6f);
        u32x2* o8 = (u32x2*)(H + (size_t)m * DM) + lane;
#pragma unroll
        for (int j = 0; j < 4; ++j) { const int col = 4 * lane + 256 * j;
            const f32x4 gv = *(const f32x4*)(g + col), sc = *(const f32x4*)(modl + b * 6144 + sc_off + col), sh = *(const f32x4*)(modl + b * 6144 + sh_off + col);
            const f32x4 y = v[j] * rstd * gv * (sc + 1.0f) + sh;
            for (int q = 0; q < 4; ++q) DBG_CHK(dbg, y[q], 0);
            o8[64 * j] = pk4(y); }
    }
}
__device__ __forceinline__ void phase_final_norm(const bf16* xb, float* out, const float* g, int wave, int lane, int G) {
    const int gw = blockIdx.x * NWAVES + wave, NGW = G * NWAVES;
    for (int m = gw; m < T; m += NGW) {
        const u32x4* xr = (const u32x4*)(xb + (size_t)m * DM) + lane;
        f32x4 v[2][2]; float ss = 0.f;
#pragma unroll
        for (int j = 0; j < 2; ++j) { const u32x4 w = xr[64 * j];
            v[j][0] = (f32x4){bflo(w.x), bfhi(w.x), bflo(w.y), bfhi(w.y)}; v[j][1] = (f32x4){bflo(w.z), bfhi(w.z), bflo(w.w), bfhi(w.w)};
#pragma unroll
            for (int n = 0; n < 2; ++n) ss += (v[j][n][0] * v[j][n][0] + v[j][n][1] * v[j][n][1]) + (v[j][n][2] * v[j][n][2] + v[j][n][3] * v[j][n][3]); }
        const float rstd = rsqrtf(wave_sum(ss) * (1.0f / DM) + 1e-6f);
        float* orow = out + (size_t)m * DM + 8 * lane;
#pragma unroll
        for (int j = 0; j < 2; ++j)
#pragma unroll
            for (int n = 0; n < 2; ++n) { const f32x4 gv = *(const f32x4*)(g + 8 * lane + 512 * j + 4 * n); *(f32x4*)(orow + 512 * j + 4 * n) = v[j][n] * rstd * gv; }
    }
}
__device__ __forceinline__ void phase_xt0(const float* xin, const float* g, const float* modl, int sc_off, bf16* H, float* SS, int wave, int lane, int G) {
    const int gw = blockIdx.x * NWAVES + wave, NGW = G * NWAVES;
    for (int m = gw; m < T; m += NGW) {
        const int b = m >> 12;
        const f32x4* xr = (const f32x4*)(xin + (size_t)m * DM) + lane;
        u32x2* o8 = (u32x2*)(H + (size_t)m * DM) + lane;
        float ss = 0.f;
#pragma unroll
        for (int j = 0; j < 4; ++j) { const f32x4 v = xr[64 * j]; ss += (v[0] * v[0] + v[1] * v[1]) + (v[2] * v[2] + v[3] * v[3]);
            const int col = 4 * lane + 256 * j;
            const f32x4 gv = *(const f32x4*)(g + col), sc = *(const f32x4*)(modl + b * 6144 + sc_off + col);
            o8[64 * j] = pk4(v * gv * (sc + 1.0f)); }
        ss = wave_sum(ss);
        if (lane < 16) SS[(size_t)m * 16 + lane] = (lane == 0) ? ss : 0.f;
    }
}
__device__ __forceinline__ void phase_bias(unsigned char* ws, int wave, int lane, int G) {
    const int gw = blockIdx.x * NWAVES + wave, NGW = G * NWAVES, fr = lane & 15, fq = lane >> 4;
    constexpr int TIN = DINP / 16, TGU = 5632 / 16, PER_L = TIN + TGU;
    for (int it = gw; it < DEPTH * PER_L; it += NGW) {
        const int l = it / PER_L; int r = it % PER_L; const bool gu = r >= TIN; if (gu) r -= TIN;
        const bf16* Wt = gu ? (const bf16*)(ws + WS_WGU) + (size_t)l * 5632 * DM : (const bf16*)(ws + WS_WIN) + (size_t)l * DINP * DM;
        const float* sh = (const float*)(ws + WS_MOD) + (size_t)l * NBATCH * 6144 + (gu ? 3072 : 0) + (size_t)fr * 6144 + 8 * fq;
        const bf16* wp = Wt + (size_t)(16 * r + fr) * DM + 8 * fq;
        f32x4 acc = (f32x4){0.f, 0.f, 0.f, 0.f};
#pragma unroll 4
        for (int ks = 0; ks < 32; ++ks) { const bf16x8 wf = *(const bf16x8*)(wp + 32 * ks);
            const f32x4 s0 = *(const f32x4*)(sh + 32 * ks), s1 = *(const f32x4*)(sh + 32 * ks + 4);
            u32x4 sw; sw.x = pk2(s0[0], s0[1]); sw.y = pk2(s0[2], s0[3]); sw.z = pk2(s1[0], s1[1]); sw.w = pk2(s1[2], s1[3]);
            acc = mfma16(wf, __builtin_bit_cast(bf16x8, sw), acc); }
        float* dst = gu ? (float*)(ws + WS_BGU) + ((size_t)l * NBATCH + fr) * 5632 : (float*)(ws + WS_BIN) + ((size_t)l * NBATCH + fr) * DINP;
        *(f32x4*)(dst + 16 * r + 4 * fq) = acc;
    }
}

constexpr int F_C = 0, F_S = 9216, F_NS = 18432, F_T0 = 27648, F_T1 = 36864, F_T2 = 46080, F_T3 = 55296, F_W = 64512;
__device__ __forceinline__ void build_dft_tables(LAS unsigned char* lds, int tid) {
    for (int i = tid; i < 4096; i += NTHR) { const int r = i >> 6, c = i & 63, m = (r * c) & 63; const float ang = (float)m * (1.0f / 32.0f);
        const float cs = cospif(ang), sn = sinpif(ang);
        const unsigned pc = pk2(cs, sn), pn = pk2(-sn, 0.f);
        *(LAS bf16*)(lds + F_C + r * 144 + c * 2) = (bf16)(pc & 0xffffu);
        *(LAS bf16*)(lds + F_S + r * 144 + c * 2) = (bf16)(pc >> 16);
        *(LAS bf16*)(lds + F_NS + r * 144 + c * 2) = (bf16)(pn & 0xffffu); }
}
__device__ __forceinline__ u32x4 fourier1_load(const bf16* P, int item, int tid) {
    const int s2 = item & 63, bg = item >> 6, g = bg & 3, b = bg >> 2, s1 = tid >> 3, c8 = tid & 7;
    return *(const u32x4*)(P + (size_t)(b * SEQ + 64 * s1 + s2) * DINP + 64 * g + 8 * c8);
}
__device__ __forceinline__ void fourier1_item(LAS unsigned char* lds, u32x4 vpre, bf16* Z2, int item, int tid, int wave, int lane, unsigned* dbg) {
    const int s2 = item & 63, bg = item >> 6, g = bg & 3, b = bg >> 2, fr = lane & 15, fq = lane >> 4;
    { const int s1 = tid >> 3, c8 = tid & 7; *(LAS u32x4*)(lds + F_T0 + s1 * 144 + c8 * 16) = vpre; }
    LDS_BARRIER();
    const int ib = wave >> 1;
    { const bf16x8 x0 = LDS_FRAG(lds + F_T0 + (16 * ib + fr) * 144 + fq * 16), x1 = LDS_FRAG(lds + F_T0 + (16 * ib + fr) * 144 + fq * 16 + 64);
#pragma unroll
      for (int jj = 0; jj < 2; ++jj) { const int jb = 2 * (wave & 1) + jj, off = (16 * jb + fr) * 144 + fq * 16;
          const bf16x8 c0 = LDS_FRAG(lds + F_C + off), c1 = LDS_FRAG(lds + F_C + off + 64), n0 = LDS_FRAG(lds + F_NS + off), n1 = LDS_FRAG(lds + F_NS + off + 64);
          f32x4 aA = mfma16(x0, c0, (f32x4){0.f, 0.f, 0.f, 0.f}); aA = mfma16(x1, c1, aA);
          f32x4 aB = mfma16(x0, n0, (f32x4){0.f, 0.f, 0.f, 0.f}); aB = mfma16(x1, n1, aB);
          for (int q = 0; q < 4; ++q) { DBG2(dbg, aA[q], 1); DBG2(dbg, aB[q], 1); }
          const int so = (16 * jb + fr) * 144 + (16 * ib + 4 * fq) * 2;
          *(LAS u32x2*)(lds + F_T2 + so) = pk4(aA); *(LAS u32x2*)(lds + F_T3 + so) = pk4(aB); } }
    LDS_BARRIER();
    { const int ao = (16 * ib + fr) * 144 + fq * 16;
      const bf16x8 a0 = LDS_FRAG(lds + F_T2 + ao), a1 = LDS_FRAG(lds + F_T2 + ao + 64), b0 = LDS_FRAG(lds + F_T3 + ao), b1 = LDS_FRAG(lds + F_T3 + ao + 64);
#pragma unroll
      for (int jj = 0; jj < 2; ++jj) { const int jb = 2 * (wave & 1) + jj, off = (16 * jb + fr) * 144 + fq * 16;
          const bf16x8 c0 = LDS_FRAG(lds + F_C + off), c1 = LDS_FRAG(lds + F_C + off + 64), s0 = LDS_FRAG(lds + F_S + off), s1 = LDS_FRAG(lds + F_S + off + 64),
                       n0 = LDS_FRAG(lds + F_NS + off), n1 = LDS_FRAG(lds + F_NS + off + 64);
          f32x4 zr = mfma16(a0, c0, (f32x4){0.f, 0.f, 0.f, 0.f}); zr = mfma16(a1, c1, zr); zr = mfma16(b0, s0, zr); zr = mfma16(b1, s1, zr);
          f32x4 zi = mfma16(b0, c0, (f32x4){0.f, 0.f, 0.f, 0.f}); zi = mfma16(b1, c1, zi); zi = mfma16(a0, n0, zi); zi = mfma16(a1, n1, zi);
          for (int q = 0; q < 4; ++q) { DBG2(dbg, zr[q], 2); DBG2(dbg, zi[q], 2); }
          const int k1 = 16 * jb + fr; const float ang = (float)(s2 * k1) * (1.0f / 2048.0f); const float ct = cospif(ang), st = sinpif(ang);
          const f32x4 wr_ = zr * ct + zi * st, wi_ = zi * ct - zr * st;
          for (int q = 0; q < 4; ++q) { DBG2(dbg, wr_[q], 3); DBG2(dbg, wi_[q], 3); }
          bf16* dst = Z2 + ((size_t)((bg * 64 + k1) * 64 + s2)) * 128 + 16 * ib + 4 * fq;
          *(u32x2*)dst = pk4(wr_); *(u32x2*)(dst + 64) = pk4(wi_); } }
}
struct F2Pre { u32x4 re, im, w; };
__device__ __forceinline__ F2Pre fourier2_load(const bf16* Z2, const bf16* WFl, int item, int tid) {
    const int g = (item >> 6) & 3, s2 = tid >> 3, c8 = tid & 7;
    const bf16* src = Z2 + ((size_t)(item * 64 + s2)) * 128 + 8 * c8;
    F2Pre p; p.re = *(const u32x4*)src; p.im = *(const u32x4*)(src + 64); p.w = *(const u32x4*)(WFl + g * 4096 + s2 * 64 + 8 * c8); return p;
}
__device__ __forceinline__ void fourier2_item(LAS unsigned char* lds, const F2Pre pre, bf16* Y, int item, int tid, int wave, int lane, unsigned* dbg) {
    const int k1 = item & 63, bg = item >> 6, g = bg & 3, b = bg >> 2, fr = lane & 15, fq = lane >> 4;
    { const int s2 = tid >> 3, c8 = tid & 7;
      *(LAS u32x4*)(lds + F_T0 + s2 * 144 + c8 * 16) = pre.re; *(LAS u32x4*)(lds + F_T1 + s2 * 144 + c8 * 16) = pre.im; *(LAS u32x4*)(lds + F_W + s2 * 144 + c8 * 16) = pre.w; }
    LDS_BARRIER();
    const int ib = wave >> 1;
    { const int xo = (16 * ib + fr) * 144 + fq * 16;
      const bf16x8 r0 = LDS_FRAG(lds + F_T0 + xo), r1 = LDS_FRAG(lds + F_T0 + xo + 64), i0 = LDS_FRAG(lds + F_T1 + xo), i1 = LDS_FRAG(lds + F_T1 + xo + 64);
#pragma unroll
      for (int jj = 0; jj < 2; ++jj) { const int jb = 2 * (wave & 1) + jj, off = (16 * jb + fr) * 144 + fq * 16;
          const bf16x8 w0 = LDS_FRAG(lds + F_W + off), w1 = LDS_FRAG(lds + F_W + off + 64);
          f32x4 qr = mfma16(r0, w0, (f32x4){0.f, 0.f, 0.f, 0.f}); qr = mfma16(r1, w1, qr);
          f32x4 qi = mfma16(i0, w0, (f32x4){0.f, 0.f, 0.f, 0.f}); qi = mfma16(i1, w1, qi);
          for (int q = 0; q < 4; ++q) { DBG2(dbg, qr[q], 5); DBG2(dbg, qi[q], 5); }
          const int so = (16 * jb + fr) * 144 + (16 * ib + 4 * fq) * 2;
          *(LAS u32x2*)(lds + F_T2 + so) = pk4(qr); *(LAS u32x2*)(lds + F_T3 + so) = pk4(qi); } }
    LDS_BARRIER();
    { const int ao = (16 * ib + fr) * 144 + fq * 16;
      const bf16x8 a0 = LDS_FRAG(lds + F_T2 + ao), a1 = LDS_FRAG(lds + F_T2 + ao + 64), b0 = LDS_FRAG(lds + F_T3 + ao), b1 = LDS_FRAG(lds + F_T3 + ao + 64);
#pragma unroll
      for (int jj = 0; jj < 2; ++jj) { const int jb = 2 * (wave & 1) + jj, off = (16 * jb + fr) * 144 + fq * 16;
          const bf16x8 c0 = LDS_FRAG(lds + F_C + off), c1 = LDS_FRAG(lds + F_C + off + 64), s0 = LDS_FRAG(lds + F_S + off), s1 = LDS_FRAG(lds + F_S + off + 64);
          f32x4 x = mfma16(a0, c0, (f32x4){0.f, 0.f, 0.f, 0.f}); x = mfma16(a1, c1, x); x = mfma16(b0, s0, x); x = mfma16(b1, s1, x);
          const int k2 = 16 * jb + fr;
          for (int q = 0; q < 8; ++q) { DBG2(dbg, bflo((unsigned)(unsigned short)c0[q]), 0); DBG2(dbg, bflo((unsigned)(unsigned short)c1[q]), 0); DBG2(dbg, bflo((unsigned)(unsigned short)s0[q]), 1); DBG2(dbg, bflo((unsigned)(unsigned short)s1[q]), 1);
              DBG2(dbg, bflo((unsigned)(unsigned short)a0[q]), 2); DBG2(dbg, bflo((unsigned)(unsigned short)a1[q]), 2); DBG2(dbg, bflo((unsigned)(unsigned short)b0[q]), 3); DBG2(dbg, bflo((unsigned)(unsigned short)b1[q]), 3); }
          for (int q = 0; q < 4; ++q) DBG2(dbg, x[q], 4);
          *(u32x2*)(Y + (size_t)(b * SEQ + k1 + 64 * k2) * DM + 64 * g + 16 * ib + 4 * fq) = pk4(x * (1.0f / 512.0f)); } }
}

constexpr int L_UB = 0, L_UF = 9216, L_AB = 26624, L_ARR = 17408, L_SEG = 96256;
struct LruPtrs { const bf16* P; const bf16* WL; const float *cw, *cb, *ba, *bx, *lam; float* car; const float* hin; bf16* Y; unsigned* dbg; };
__device__ __forceinline__ float one_minus_exp(float w) {
    const float ser = -w * (1.0f + w * (0.5f + w * (0.16666667f + w * 0.041666668f)));
    return (w > -0.03f) ? ser : 1.0f - __expf(w);
}
template <int PASS> __device__ __forceinline__ void lru_phase(LAS unsigned char* lds, const LruPtrs& q, int l, int tid, int wave, int lane, int G) {
    constexpr int NIT = NBATCH * 64 * 6;
    const int fr = lane & 15, fq = lane >> 4;
    const int ct = tid >> 3, c8 = tid & 7;
    const int gdir = wave >> 2, geb = wave & 3;
    const int e0 = 16 * geb + 4 * fq;
    float cw[4][8], cbv[8];
    bf16x8 wa0, wa1, wx0, wx1; f32x4 ba, bx, sp;
    int hcur = -1;
    u32x4 pxn[4]; u32x4 pgn; float hinn = 0.f;
    const int per_blk = (NIT + G - 1) / G;
    int it = blockIdx.x * per_blk; const int it_end = min(it + per_blk, NIT);
    auto issue = [&](int item) {
        const int h = item >> 10, br = item & 1023, r = br & 63, b = br >> 6;
        const int ch0 = 64 * h + 8 * c8;
#pragma unroll
        for (int k = 0; k < 4; ++k) { const int s = 64 * r + ct + k - 2; const int sc = min(max(s, 0), SEQ - 1);
            pxn[k] = *(const u32x4*)(q.P + (size_t)(b * SEQ + sc) * DINP + 256 + ch0); }
        if (PASS == 2) { pgn = *(const u32x4*)(q.P + (size_t)(b * SEQ + 64 * r + ct) * DINP + 640 + ch0);
            hinn = q.hin[((b * 64 + r) * 2 + (wave >> 2)) * DLRU + 64 * h + lane]; }
    };
    if (it < it_end) issue(it);
    for (; it < it_end; ++it) {
        const int h = it >> 10, br = it & 1023, r = br & 63, b = br >> 6;
        const int t0 = b * SEQ + 64 * r;
        if (h != hcur) { hcur = h;
            const int ch0 = 64 * h + 8 * c8;
#pragma unroll
            for (int k = 0; k < 4; ++k) { const f32x4 w0 = *(const f32x4*)(q.cw + (l * 4 + k) * DLRU + ch0), w1 = *(const f32x4*)(q.cw + (l * 4 + k) * DLRU + ch0 + 4);
                cw[k][0] = w0[0]; cw[k][1] = w0[1]; cw[k][2] = w0[2]; cw[k][3] = w0[3]; cw[k][4] = w1[0]; cw[k][5] = w1[1]; cw[k][6] = w1[2]; cw[k][7] = w1[3]; }
            { const f32x4 c0 = *(const f32x4*)(q.cb + l * DLRU + ch0), c1 = *(const f32x4*)(q.cb + l * DLRU + ch0 + 4);
              cbv[0] = c0[0]; cbv[1] = c0[1]; cbv[2] = c0[2]; cbv[3] = c0[3]; cbv[4] = c1[0]; cbv[5] = c1[1]; cbv[6] = c1[2]; cbv[7] = c1[3]; }
            const bf16* Wa = q.WL + (size_t)((((l * 2 + gdir) * 2 + 0) * 6) + h) * 4096 + (16 * geb + fr) * 64 + 8 * fq;
            const bf16* Wx = q.WL + (size_t)((((l * 2 + gdir) * 2 + 1) * 6) + h) * 4096 + (16 * geb + fr) * 64 + 8 * fq;
            wa0 = *(const bf16x8*)Wa; wa1 = *(const bf16x8*)(Wa + 32); wx0 = *(const bf16x8*)Wx; wx1 = *(const bf16x8*)(Wx + 32);
            const int chg = (l * 2 + gdir) * DLRU + 64 * h + e0;
            ba = *(const f32x4*)(q.ba + chg) * -1.4426950408889634f; bx = *(const f32x4*)(q.bx + chg) * -1.4426950408889634f;
            const f32x4 lam = *(const f32x4*)(q.lam + chg);
#pragma unroll
            for (int j = 0; j < 4; ++j) sp[j] = -8.0f * 1.4426950408889634f * log1pf(expf(-lam[j])); }
        { float u[8];
#pragma unroll
          for (int j = 0; j < 8; ++j) u[j] = cbv[j];
#pragma unroll
          for (int k = 0; k < 4; ++k) { const int sq = 64 * r + ct + k - 2; const bool inb = (sq >= 0) && (sq < SEQ);
              u32x4 raw = pxn[k]; if (!inb) raw = (u32x4){0u, 0u, 0u, 0u};
              u[0] += cw[k][0] * bflo(raw.x); u[1] += cw[k][1] * bfhi(raw.x); u[2] += cw[k][2] * bflo(raw.y); u[3] += cw[k][3] * bfhi(raw.y);
              u[4] += cw[k][4] * bflo(raw.z); u[5] += cw[k][5] * bfhi(raw.z); u[6] += cw[k][6] * bflo(raw.w); u[7] += cw[k][7] * bfhi(raw.w); }
          u32x4 pb; pb.x = pk2(u[0], u[1]); pb.y = pk2(u[2], u[3]); pb.z = pk2(u[4], u[5]); pb.w = pk2(u[6], u[7]);
          *(LAS u32x4*)(lds + L_UB + ct * 144 + c8 * 16) = pb;
          *(LAS f32x4*)(lds + L_UF + (ct * 68 + 8 * c8) * 4) = (f32x4){u[0], u[1], u[2], u[3]};
          *(LAS f32x4*)(lds + L_UF + (ct * 68 + 8 * c8 + 4) * 4) = (f32x4){u[4], u[5], u[6], u[7]}; }
        const u32x4 graw = pgn; const float hin_cur = hinn;
        if (it + 1 < it_end) issue(it + 1);
        LDS_BARRIER();
        { LAS unsigned char* Aa = lds + L_AB + gdir * 2 * L_ARR; LAS unsigned char* Bb = Aa + L_ARR;
#pragma unroll
          for (int tb = 0; tb < 4; ++tb) { const int t = 16 * tb + fr;
              const bf16x8 u0 = LDS_FRAG(lds + L_UB + t * 144 + fq * 16), u1 = LDS_FRAG(lds + L_UB + t * 144 + fq * 16 + 64);
              f32x4 ga = mfma16(wa0, u0, (f32x4){0.f, 0.f, 0.f, 0.f}); ga = mfma16(wa1, u1, ga);
              f32x4 gx = mfma16(wx0, u0, (f32x4){0.f, 0.f, 0.f, 0.f}); gx = mfma16(wx1, u1, gx);
              const f32x4 uf = *(const LAS f32x4*)(lds + L_UF + (t * 68 + e0) * 4);
              f32x4 av, bv;
#pragma unroll
              for (int j = 0; j < 4; ++j) {
                  const float d1 = 1.0f + __builtin_amdgcn_exp2f(fminf(ga[j] + ba[j], 30.0f)), d2 = 1.0f + __builtin_amdgcn_exp2f(fminf(gx[j] + bx[j], 30.0f));
                  const float rc = __builtin_amdgcn_rcpf(d1 * d2), rg = rc * d2, ig = rc * d1;
                  const float aa = __builtin_amdgcn_exp2f(rg * sp[j]);
                  av[j] = aa; bv[j] = __builtin_amdgcn_sqrtf(fmaf(-aa, aa, 1.0f)) * (ig * uf[j]); }
              *(LAS f32x4*)(Aa + (t * 68 + e0) * 4) = av; *(LAS f32x4*)(Bb + (t * 68 + e0) * 4) = bv; } }
        LDS_BARRIER();
        { const int dir = wave >> 2, seg = wave & 3, e = lane;
          const LAS float* ap = (const LAS float*)(lds + L_AB + dir * 2 * L_ARR) + (16 * seg) * 68 + e;
          LAS float* bp = (LAS float*)(lds + L_AB + dir * 2 * L_ARR + L_ARR) + (16 * seg) * 68 + e;
          float av[16], bv[16];
#pragma unroll
          for (int i = 0; i < 16; ++i) { av[i] = ap[i * 68]; bv[i] = bp[i * 68]; }
          float Pm = 1.f, H = 0.f;
          if (dir == 0) {
#pragma unroll
              for (int i = 0; i < 16; ++i) { H = av[i] * H + bv[i]; Pm *= av[i]; } }
          else {
#pragma unroll
              for (int i = 15; i >= 0; --i) { H = av[i] * H + bv[i]; Pm *= av[i]; } }
          typedef float f32x2v __attribute__((ext_vector_type(2)));
          LAS f32x2v* sg = (LAS f32x2v*)(lds + L_SEG);
          sg[(dir * 4 + seg) * 64 + e] = (f32x2v){Pm, H};
          LDS_BARRIER();
          if (PASS == 1) {
              if (seg == 0) { float Pc = 1.f, Hc = 0.f;
#pragma unroll
                  for (int s = 0; s < 4; ++s) { const f32x2v ph = sg[(dir * 4 + (dir == 0 ? s : 3 - s)) * 64 + e]; Hc = ph.x * Hc + ph.y; Pc *= ph.x; }
                  *(float2*)(q.car + 2 * (size_t)(((b * 64 + r) * 2 + dir) * DLRU + 64 * h + e)) = make_float2(Pc, Hc); }
          } else {
              float Hc = hin_cur;
#pragma unroll
              for (int s = 0; s < 3; ++s) { const int sidx = (dir == 0) ? s : 3 - s; const bool use = (dir == 0) ? (s < seg) : (sidx > seg);
                  const f32x2v ph = sg[(dir * 4 + sidx) * 64 + e]; if (use) Hc = ph.x * Hc + ph.y; }
              if (dir == 0) {
#pragma unroll
                  for (int i = 0; i < 16; ++i) { Hc = av[i] * Hc + bv[i]; bp[i * 68] = Hc; } }
              else {
#pragma unroll
                  for (int i = 15; i >= 0; --i) { Hc = av[i] * Hc + bv[i]; bp[i * 68] = Hc; } }
          } }
        if (PASS == 2) {
            LDS_BARRIER();
            const size_t tok = (size_t)(t0 + ct);
            const LAS float* B0 = (const LAS float*)(lds + L_AB + L_ARR) + ct * 68 + 8 * c8; const LAS float* B1 = (const LAS float*)(lds + L_AB + 3 * L_ARR) + ct * 68 + 8 * c8;
            const f32x4 h0 = *(const LAS f32x4*)B0 + *(const LAS f32x4*)B1, h1 = *(const LAS f32x4*)(B0 + 4) + *(const LAS f32x4*)(B1 + 4);
            float gv[8] = {bflo(graw.x), bfhi(graw.x), bflo(graw.y), bfhi(graw.y), bflo(graw.z), bfhi(graw.z), bflo(graw.w), bfhi(graw.w)};
            float hs[8] = {h0[0], h0[1], h0[2], h0[3], h1[0], h1[1], h1[2], h1[3]}, y[8];
#pragma unroll
            for (int j = 0; j < 8; ++j) { const float x = gv[j], z = 0.7978845608028654f * (x + 0.044715f * x * x * x); y[j] = x * sigmoidf_(2.0f * z) * hs[j]; }
            u32x4 o; o.x = pk2(y[0], y[1]); o.y = pk2(y[2], y[3]); o.z = pk2(y[4], y[5]); o.w = pk2(y[6], y[7]);
            *(u32x4*)(q.Y + tok * DM + 256 + 64 * h + 8 * c8) = o;
        }
        LDS_BARRIER();
    }
}
__device__ __forceinline__ void lru_carry_scan(const float* car, float* hin, int tid) {
    const int gt = blockIdx.x * NTHR + tid;
    if (gt < NBATCH * 2 * DLRU) { const int ch = gt % DLRU, dir = (gt / DLRU) & 1, b = gt / (2 * DLRU);
        typedef float f32x2c __attribute__((ext_vector_type(2)));
        float H = 0.f;
#pragma unroll 1
        for (int rb = 0; rb < 4; ++rb) {
            f32x2c pe[16];
#pragma unroll
            for (int k = 0; k < 16; ++k) { const int r = (dir == 0) ? (16 * rb + k) : (63 - 16 * rb - k);
                pe[k] = *(const f32x2c*)(car + 2 * (size_t)(((b * 64 + r) * 2 + dir) * DLRU + ch)); }
            __builtin_amdgcn_sched_barrier(0);
#pragma unroll
            for (int k = 0; k < 16; ++k) { const int r = (dir == 0) ? (16 * rb + k) : (63 - 16 * rb - k);
                hin[((b * 64 + r) * 2 + dir) * DLRU + ch] = H; H = pe[k].x * H + pe[k].y; }
            __builtin_amdgcn_sched_barrier(0); } }
}

constexpr int N_K = 0, N_V = 73728, N_VS = 584, N_RPB = 148480;
constexpr float LOG2E = 1.4426950408889634f;
__device__ __forceinline__ void na_store_row(LAS unsigned char* lds, int slot, int col, int ch, u32x4 kraw, u32x4 vraw) {
    const int key = slot * 64 + col;
    *(LAS u32x4*)(lds + N_K + key * 128 + ((ch ^ (key & 7)) << 4)) = kraw;
    LAS bf16* vt = (LAS bf16*)(lds + N_V) + (8 * ch) * N_VS + key;
    vt[0 * N_VS] = (bf16)(vraw.x & 0xffffu); vt[1 * N_VS] = (bf16)(vraw.x >> 16); vt[2 * N_VS] = (bf16)(vraw.y & 0xffffu); vt[3 * N_VS] = (bf16)(vraw.y >> 16);
    vt[4 * N_VS] = (bf16)(vraw.z & 0xffffu); vt[5 * N_VS] = (bf16)(vraw.z >> 16); vt[6 * N_VS] = (bf16)(vraw.w & 0xffffu); vt[7 * N_VS] = (bf16)(vraw.w >> 16);
}
__device__ __forceinline__ void na_phase(LAS unsigned char* lds, const bf16* P, const float* rpb, bf16* Y, int tid, int wave, int lane, int G) {
    const int fr = lane & 15, fq = lane >> 4;
    const int rsel = wave >> 2, qb = wave & 3;
    const int kstart = min(max(16 * qb - 8, 0), 32);
    const int c = 16 * qb + fr, cs = min(max(c - 8, 0), 48);
    float madd[2][4]; int dcc[2][4];
#pragma unroll
    for (int t = 0; t < 2; ++t)
#pragma unroll
        for (int j = 0; j < 4; ++j) { const int kc = kstart + 16 * t + 4 * fq + j; madd[t][j] = (kc >= cs && kc < cs + 16) ? 0.0f : -1e30f; dcc[t][j] = min(max(kc - c + 15, 0), 30); }
    const int lcol = tid >> 3, lch = tid & 7;
    const LAS float* rl = (const LAS float*)(lds + N_RPB);
    for (int run = blockIdx.x; run < NBATCH * 6 * 8; run += G) {
        const int bh = run >> 3, kq = run & 7, h = bh % 6, b = bh / 6;
        const bf16* Pb = P + (size_t)b * SEQ * DINP + 64 * h;
        LDS_BARRIER();
        { const int bl0 = min(max(8 * kq - 4, 0), 56);
          u32x4 kk[9], vv[9];
#pragma unroll
          for (int i = 0; i < 9; ++i) { const bf16* src = Pb + (size_t)((bl0 + i) * 64 + lcol) * DINP + 8 * lch;
              kk[i] = *(const u32x4*)(src + 1408); vv[i] = *(const u32x4*)(src + 1792); }
          __builtin_amdgcn_sched_barrier(0);
#pragma unroll
          for (int i = 0; i < 9; ++i) na_store_row(lds, (bl0 + i) % 9, lcol, lch, kk[i], vv[i]);
          if (tid < 465) ((LAS float*)(lds + N_RPB))[tid] = rpb[h * 465 + tid] * LOG2E; }
        bf16x8 qn0, qn1;
        { const bf16* qp = Pb + (size_t)((8 * kq + rsel) * 64 + c) * DINP + 1024 + 8 * fq; qn0 = *(const bf16x8*)qp; qn1 = *(const bf16x8*)(qp + 32); }
        LDS_BARRIER();
#pragma unroll 1
        for (int i = 0; i < 4; ++i) {
            const int r0 = 8 * kq + 2 * i, band_lo = min(max(r0 - 4, 0), 56);
            const bool more = i < 3; const int bln = min(max(r0 - 2, 0), 56); const bool shift = more && (bln != band_lo);
            const bf16x8 q0 = qn0, q1 = qn1;
            u32x4 kpre[2], vpre[2];
            if (more) { const bf16* qp = Pb + (size_t)((r0 + 2 + rsel) * 64 + c) * DINP + 1024 + 8 * fq; qn0 = *(const bf16x8*)qp; qn1 = *(const bf16x8*)(qp + 32); }
#pragma unroll
            for (int j = 0; j < 2; ++j) { const int grow = min(band_lo + 9 + j, 63); const bf16* src = Pb + (size_t)(grow * 64 + lcol) * DINP + 8 * lch;
                if (shift) { kpre[j] = *(const u32x4*)(src + 1408); vpre[j] = *(const u32x4*)(src + 1792); } }
            { const int r = r0 + rsel, rs = min(max(r - 4, 0), 56);
              const int slot0 = rs % 9;
              f32x4 s[8][2]; float mx = -1e30f;
#pragma unroll
              for (int g2 = 0; g2 < 4; ++g2) {
                  bf16x8 kf[2][2][2]; float bw[2][2][4];
#pragma unroll
                  for (int u = 0; u < 2; ++u) { const int kr = 2 * g2 + u; int slot = slot0 + kr; slot = (slot >= 9) ? slot - 9 : slot; const int dr31 = (rs + kr - r + 7) * 31;
#pragma unroll
                      for (int t = 0; t < 2; ++t) { const int key = slot * 64 + kstart + 16 * t + fr; const LAS unsigned char* ka = lds + N_K + key * 128;
                          kf[u][t][0] = LDS_FRAG(ka + ((fq ^ (key & 7)) << 4)); kf[u][t][1] = LDS_FRAG(ka + (((4 + fq) ^ (key & 7)) << 4));
#pragma unroll
                          for (int j = 0; j < 4; ++j) bw[u][t][j] = rl[dr31 + dcc[t][j]]; } }
                  __builtin_amdgcn_sched_barrier(0);
#pragma unroll
                  for (int u = 0; u < 2; ++u)
#pragma unroll
                      for (int t = 0; t < 2; ++t) { f32x4 acc = mfma16(kf[u][t][0], q0, (f32x4){0.f, 0.f, 0.f, 0.f}); acc = mfma16(kf[u][t][1], q1, acc);
#pragma unroll
                          for (int j = 0; j < 4; ++j) { const float v = (acc[j] + bw[u][t][j]) + madd[t][j]; acc[j] = v; mx = fmaxf(mx, v); }
                          s[2 * g2 + u][t] = acc; }
                  __builtin_amdgcn_sched_barrier(0); }
              mx = fmaxf(mx, __shfl_xor(mx, 16)); mx = fmaxf(mx, __shfl_xor(mx, 32));
              float sum = 0.f;
#pragma unroll
              for (int kr = 0; kr < 8; ++kr)
#pragma unroll
                  for (int t = 0; t < 2; ++t)
#pragma unroll
                      for (int j = 0; j < 4; ++j) { const float p = __builtin_amdgcn_exp2f(s[kr][t][j] - mx); s[kr][t][j] = p; sum += p; }
              sum += __shfl_xor(sum, 16); sum += __shfl_xor(sum, 32);
              f32x4 O[4];
#pragma unroll
              for (int db = 0; db < 4; ++db) O[db] = (f32x4){0.f, 0.f, 0.f, 0.f};
              const LAS bf16* vbase = (const LAS bf16*)(lds + N_V) + fr * N_VS + kstart + 4 * fq;
              u32x2 va[2][4], vb[2][4];
#pragma unroll
              for (int db = 0; db < 4; ++db) { const LAS bf16* vp = vbase + 16 * db * N_VS + slot0 * 64; va[0][db] = *(const LAS u32x2*)vp; vb[0][db] = *(const LAS u32x2*)(vp + 16); }
#pragma unroll
              for (int kr = 0; kr < 8; ++kr) {
                  if (kr < 7) { int slot = slot0 + kr + 1; slot = (slot >= 9) ? slot - 9 : slot;
#pragma unroll
                      for (int db = 0; db < 4; ++db) { const LAS bf16* vp = vbase + 16 * db * N_VS + slot * 64; va[(kr + 1) & 1][db] = *(const LAS u32x2*)vp; vb[(kr + 1) & 1][db] = *(const LAS u32x2*)(vp + 16); } }
                  __builtin_amdgcn_sched_barrier(0);
                  const u32x2 pa = pk4(s[kr][0]), pb = pk4(s[kr][1]); u32x4 pw; pw.x = pa.x; pw.y = pa.y; pw.z = pb.x; pw.w = pb.y;
                  const bf16x8 pf = __builtin_bit_cast(bf16x8, pw);
#pragma unroll
                  for (int db = 0; db < 4; ++db) { u32x4 vw; vw.x = va[kr & 1][db].x; vw.y = va[kr & 1][db].y; vw.z = vb[kr & 1][db].x; vw.w = vb[kr & 1][db].y;
                      O[db] = mfma16(__builtin_bit_cast(bf16x8, vw), pf, O[db]); }
                  __builtin_amdgcn_sched_barrier(0); }
              const float inv = __builtin_amdgcn_rcpf(sum);
              bf16* yp = Y + (size_t)(b * SEQ + r * 64 + c) * DM + 640 + 64 * h + 4 * fq;
#pragma unroll
              for (int db = 0; db < 4; ++db) *(u32x2*)(yp + 16 * db) = pk4(O[db] * inv); }
            if (more) {
                LDS_BARRIER();
                if (shift) {
#pragma unroll
                    for (int j = 0; j < 2; ++j) { const int grow = band_lo + 9 + j; if (grow <= 63) na_store_row(lds, grow % 9, lcol, lch, kpre[j], vpre[j]); } }
                LDS_BARRIER();
            }
        }
    }
    LDS_BARRIER();
}

typedef __attribute__((address_space(1))) unsigned gu32;
#define RLX_AGENT __ATOMIC_RELAXED, __HIP_MEMORY_SCOPE_AGENT
#define XB_TMO      128
#define XB_XCNT(j)  (256  + 64 * (j))
#define XB_XSUB(j)  (1280 + 64 * (j))
#define XB_XGEN(j)  (2304 + 64 * (j))
#define XB_TOP      3328
#define XB_TOPGEN   3392
#define XCD_BAR_WORDS 3456
#define XB_SPIN_CAP (1u << 18)

__device__ __forceinline__ unsigned xb_ld(unsigned* p)              { return __hip_atomic_load(p, __ATOMIC_RELAXED, __HIP_MEMORY_SCOPE_AGENT); }
__device__ __forceinline__ unsigned xb_add(unsigned* p, unsigned v) { return __hip_atomic_fetch_add(p, v, __ATOMIC_RELAXED, __HIP_MEMORY_SCOPE_AGENT); }
__device__ __forceinline__ unsigned xb_xcc_id() { return (unsigned)__builtin_amdgcn_s_getreg((3 << 11) | 20) & 0xFu; }
#define XB_SPIN(cond, bar) do { unsigned _sp = 0; while (cond) { __builtin_amdgcn_s_sleep(1); \
    if ((++_sp & 255u) == 0u) { if (xb_ld(&(bar)[XB_TMO])) break; if (_sp > XB_SPIN_CAP) { atomicAdd(&(bar)[XB_TMO], 1u); break; } } } } while (0)

struct XcdBarrier {
    unsigned* bar; unsigned x;
    volatile LAS unsigned* st;
};

__device__ __forceinline__ XcdBarrier xcd_barrier_post(unsigned* bar, volatile LAS unsigned* st) {
    XcdBarrier b; b.bar = bar; b.x = xb_xcc_id(); b.st = st;
    if (threadIdx.x == 0) (void)xb_add(&bar[XB_XCNT(b.x)], 1u);
    return b;
}
__device__ __forceinline__ void xcd_barrier_complete(unsigned* bar, unsigned x, unsigned& nloc, unsigned& nx) {
    const unsigned G = gridDim.x * gridDim.y * gridDim.z;
    unsigned sum, cnt, mine, sp = 0u;
    for (;;) {
        sum = 0u; cnt = 0u; mine = 0u;
#pragma unroll
        for (unsigned j = 0; j < 16; ++j) { const unsigned c = xb_ld(&bar[XB_XCNT(j)]); sum += c; cnt += (c > 0u) ? 1u : 0u; mine = (j == x) ? c : mine; }
        if (sum == G) break;
        __builtin_amdgcn_s_sleep(1);
        if ((++sp & 255u) == 0u) { if (xb_ld(&bar[XB_TMO])) break; if (sp > XB_SPIN_CAP) { atomicAdd(&bar[XB_TMO], 1u); break; } }
    }
    nloc = mine > 0u ? mine : 1u; nx = cnt > 0u ? cnt : 1u;
}

__device__ __forceinline__ void xcd_barrier(const XcdBarrier& b) {
    asm volatile("s_waitcnt vmcnt(0)" ::: "memory");
    __syncthreads();
    if (threadIdx.x == 0) {
        unsigned* bar = b.bar;
        __builtin_amdgcn_s_waitcnt(0);
        unsigned nloc = b.st[0], nx = b.st[1];
        if (nloc == 0u) { xcd_barrier_complete(bar, b.x, nloc, nx); b.st[0] = nloc; b.st[1] = nx; }
        const unsigned old = xb_add(&bar[XB_XSUB(b.x)], 1u);
        const unsigned gen = old / nloc;
        if (old + 1u == (gen + 1u) * nloc) {
            __builtin_amdgcn_fence(__ATOMIC_RELEASE, "agent");
            asm volatile("s_waitcnt vmcnt(0)" ::: "memory");
            const unsigned og = xb_add(&bar[XB_TOP], 1u);
            const unsigned tg = og / nx;
            if (og + 1u == (tg + 1u) * nx) xb_add(&bar[XB_TOPGEN], 1u);
            else XB_SPIN(xb_ld(&bar[XB_TOPGEN]) == tg, bar);
            __builtin_amdgcn_fence(__ATOMIC_ACQUIRE, "agent");
            xb_add(&bar[XB_XGEN(b.x)], 1u);
            asm volatile("s_waitcnt vmcnt(0)" ::: "memory");
        } else {
            XB_SPIN(xb_ld(&bar[XB_XGEN(b.x)]) == gen, bar);
            __builtin_amdgcn_fence(__ATOMIC_ACQUIRE, "agent");
            asm volatile("s_waitcnt vmcnt(0)" ::: "memory");
        }
    }
    __syncthreads();
}


#ifndef REP_NA
#define REP_NA 1
#endif
#ifndef REP_F
#define REP_F 1
#endif
#ifndef REP_L
#define REP_L 1
#endif
#ifndef REP_N
#define REP_N 1
#endif
#ifndef REP_G1
#define REP_G1 1
#endif
#ifndef REP_G3
#define REP_G3 1
#endif
#ifndef REP_S
#define REP_S 1
#endif
__global__ void __launch_bounds__(NTHR, 2) fwd_megakernel(Args a) {
    extern __shared__ __attribute__((aligned(16))) unsigned char lds_raw[];
    LAS unsigned char* lds = (LAS unsigned char*)lds_raw;
    cg::grid_group grid = cg::this_grid();
    const int G = gridDim.x;
#define GRID_SYNC_CG() do { asm volatile("s_waitcnt vmcnt(0) lgkmcnt(0)" ::: "memory"); grid.sync(); __builtin_amdgcn_fence(__ATOMIC_ACQUIRE, "agent"); asm volatile("s_waitcnt vmcnt(0)" ::: "memory"); } while (0)
#define GRID_SYNC() do { for (int rs_ = 0; rs_ < REP_S; ++rs_) xcd_barrier(xbar); } while (0)
#define FRESH() int t_ = threadIdx.x; asm volatile("" : "+v"(t_)); const int tid = t_, lane = tid & 63, wave = __builtin_amdgcn_readfirstlane(tid >> 6); (void)lane; (void)wave;
    unsigned char* ws = a.ws;
    bf16* const Hb = (bf16*)(ws + WS_H); bf16* const Pb = (bf16*)(ws + WS_P); bf16* const Yb = (bf16*)(ws + WS_Y); bf16* const HIDb = (bf16*)(ws + WS_HID);
    bf16* const Z2 = (bf16*)(ws + WS_H);
    float* const out = a.out;
    volatile LAS unsigned* xst = (volatile LAS unsigned*)(lds + LDS_BYTES - 16);
    if (threadIdx.x < 4) xst[threadIdx.x] = 0u;
    __syncthreads();
    const XcdBarrier xbar = xcd_barrier_post((unsigned*)(ws + WS_BAR), xst);

#ifndef REP_PA
#define REP_PA 1
#endif
    for (int rep = 0; rep < REP_PA; ++rep) { FRESH(); phase_prologue_a(a, lds, tid, wave, lane, G); __syncthreads(); }
    GRID_SYNC_CG();
    { FRESH(); phase_prologue_b(a, tid, G); }
    GRID_SYNC();

    { FRESH(); phase_xt0(a.in[0], a.in[4], (const float*)(ws + WS_MOD), 1024, Hb, (float*)(ws + WS_SS), wave, lane, G); phase_bias(ws, wave, lane, G); }
    GRID_SYNC();
    float* const SSb = (float*)(ws + WS_SS);
    bf16* const XBb = (bf16*)(ws + WS_XB);
    for (int l = 0; l < DEPTH; ++l) {
        const float* modl = (const float*)(ws + WS_MOD) + (size_t)l * NBATCH * 6144;
        for (int rep = 0; rep < REP_G1; ++rep) { pg8::Gemm g{Hb, (const bf16*)(ws + WS_WIN) + (size_t)l * DINP * DM, T, DINP, DM}; pg8::StaticOrder S; S.init(T, DINP, G, (int)blockIdx.x);
          pg8::EpiP E{Pb, DINP, SSb, (const float*)(ws + WS_BIN) + (size_t)l * NBATCH * DINP, DINP};
          pg8::gemm_phase<pg8::EpiP, pg8::StaticOrder, true, true>(lds, g, S, E); }
        GRID_SYNC();
        LruPtrs lp{Pb, (const bf16*)(ws + WS_WLRU), a.in[8], a.in[9], a.in[11], a.in[13], a.in[14], (float*)(ws + WS_CAR), (const float*)(ws + WS_HIN), Yb, nullptr};
        for (int rep = 0; rep < REP_L; ++rep) { FRESH(); lru_phase<1>(lds, lp, l, tid, wave, lane, G); }
        GRID_SYNC();
        { FRESH(); lru_carry_scan((const float*)(ws + WS_CAR), (float*)(ws + WS_HIN), tid); }
        for (int rep = 0; rep < REP_F; ++rep) { FRESH(); build_dft_tables(lds, tid); __syncthreads();
          { int it = blockIdx.x; u32x4 cur = fourier1_load(Pb, it < NBATCH * 4 * 64 ? it : 0, tid);
            for (; it < NBATCH * 4 * 64; it += G) { u32x4 nxt = cur; if (it + G < NBATCH * 4 * 64) nxt = fourier1_load(Pb, it + G, tid);
                fourier1_item(lds, cur, Z2, it, tid, wave, lane, nullptr); cur = nxt; } }
          __syncthreads(); }
        for (int rep = 0; rep < REP_NA; ++rep) { FRESH(); na_phase(lds, Pb, a.in[15] + (size_t)l * 6 * 465, Yb, tid, wave, lane, G); }
        GRID_SYNC();
        for (int rep = 0; rep < REP_F; ++rep) { FRESH(); build_dft_tables(lds, tid); __syncthreads();
          { const bf16* WFl = (const bf16*)(ws + WS_WF) + (size_t)l * 4 * 4096; int it = blockIdx.x; F2Pre cur = fourier2_load(Z2, WFl, it < NBATCH * 4 * 64 ? it : 0, tid);
            for (; it < NBATCH * 4 * 64; it += G) { F2Pre nxt = cur; if (it + G < NBATCH * 4 * 64) nxt = fourier2_load(Z2, WFl, it + G, tid);
                fourier2_item(lds, cur, Yb, it, tid, wave, lane, nullptr); cur = nxt; } }
          __syncthreads(); }
        for (int rep = 0; rep < REP_L; ++rep) { FRESH(); lru_phase<2>(lds, lp, l, tid, wave, lane, G); }
        GRID_SYNC();
        { pg8::Gemm g{Yb, (const bf16*)(ws + WS_WOUT) + (size_t)l * DM * DM, T, DM, DM}; pg8::StaticOrder S; S.init(T, DM, G, (int)blockIdx.x);
          pg8::EpiRes E{l == 0 ? a.in[0] : nullptr, l == 0 ? nullptr : XBb, XBb, modl + 2048, a.in[5] + l * DM, modl + 4096, Hb, SSb};
          pg8::gemm_phase<pg8::EpiRes, pg8::StaticOrder, true, true>(lds, g, S, E); }
        GRID_SYNC();
        for (int rep = 0; rep < REP_G3; ++rep) { pg8::Gemm g{Hb, (const bf16*)(ws + WS_WGU) + (size_t)l * 5632 * DM, T, 5632, DM}; pg8::StaticOrder S; S.init(T, 5632, G, (int)blockIdx.x);
          pg8::EpiSwiGLU E{HIDb, SSb, (const float*)(ws + WS_BGU) + (size_t)l * NBATCH * 5632};
          pg8::gemm_phase<pg8::EpiSwiGLU, pg8::StaticOrder, true, true>(lds, g, S, E); }
        GRID_SYNC();
        { pg8::Gemm g{HIDb, (const bf16*)(ws + WS_WDN) + (size_t)l * DM * DFF, T, DM, DFF}; pg8::StaticOrder S; S.init(T, DM, G, (int)blockIdx.x);
          const bool more = (l + 1 < DEPTH);
          pg8::EpiRes E{nullptr, XBb, XBb, modl + 5120, more ? a.in[4] + (l + 1) * DM : nullptr, more ? modl + NBATCH * 6144 + 1024 : modl, Hb, SSb};
          pg8::gemm_phase<pg8::EpiRes, pg8::StaticOrder, true, true>(lds, g, S, E); }
        GRID_SYNC();
    }
    { FRESH(); phase_final_norm(XBb, out, a.in[20], wave, lane, G); }
}

extern "C" void kernel_launch(void* const* d_in, const int* in_sizes, int n_in, void* d_out, int out_size, void* d_ws, size_t ws_size, hipStream_t stream) {
    static int grid_blocks = 0;
    if (grid_blocks == 0) {
        if (n_in != 21 || out_size != T * DM || ws_size < WS_END) { fprintf(stderr, "kernel_launch: unexpected problem (n_in %d, out %d, ws %zu)\n", n_in, out_size, ws_size); grid_blocks = -1; return; }
        int dev = 0, cus = 0, per_cu = 0;
        hipGetDevice(&dev);
        hipDeviceGetAttribute(&cus, hipDeviceAttributeMultiprocessorCount, dev);
        if (hipFuncSetAttribute((const void*)fwd_megakernel, hipFuncAttributeMaxDynamicSharedMemorySize, LDS_BYTES) != hipSuccess) { fprintf(stderr, "kernel_launch: hipFuncSetAttribute failed\n"); grid_blocks = -1; return; }
        if (hipOccupancyMaxActiveBlocksPerMultiprocessor(&per_cu, (const void*)fwd_megakernel, NTHR, LDS_BYTES) != hipSuccess || per_cu < 1) { fprintf(stderr, "kernel_launch: occupancy query failed (%d)\n", per_cu); per_cu = 1; (void)hipGetLastError(); }
        grid_blocks = cus * per_cu;
    }
    if (grid_blocks < 0) return;
    Args a{};
    for (int i = 0; i < 21; ++i) a.in[i] = (const float*)d_in[i];
    a.out = (float*)d_out; a.ws = (unsigned char*)d_ws;
    if (hipMemsetAsync((unsigned char*)d_ws + WS_BAR, 0, XCD_BAR_WORDS * 4, stream) != hipSuccess) { fprintf(stderr, "kernel_launch: memset of the barrier words failed\n"); return; }
    void* args[] = {&a};
    hipError_t e = hipLaunchCooperativeKernel((const void*)fwd_megakernel, dim3(grid_blocks), dim3(NTHR), args, LDS_BYTES, stream);
    if (e != hipSuccess) fprintf(stderr, "cooperative launch failed: %s (grid %d)\n", hipGetErrorString(e), grid_blocks);
}
```

```cpp
#include <hip/hip_runtime.h>
#include <hip/hip_cooperative_groups.h>
#include <cstdio>
#include <cstdint>
namespace cg = cooperative_groups;
namespace pg8 {
#define PG8_LAS __attribute__((address_space(3)))
typedef unsigned short bf16_t;
typedef short bf16x8 __attribute__((ext_vector_type(8)));
typedef float f32x4 __attribute__((ext_vector_type(4)));
typedef unsigned u32x4 __attribute__((ext_vector_type(4)));
typedef unsigned u32x2 __attribute__((ext_vector_type(2)));
constexpr int BM = 256, BK = 64, HALF = 128, HTB = HALF * BK * 2  , STAGE_BYTES = 8 * HTB, NXCD = 8, WGM = 8;

__host__ __device__ __forceinline__ int lds_byte(int r, int c) { const int st = (r >> 4) * 2 + (c >> 5), rr = r & 15, cc = c & 31, ob = rr * 64 + cc * 2; return st * 1024 + (ob ^ (((ob >> 9) & 1) << 5)); }
__host__ __device__ __forceinline__ void stage_rc(int b, int& R, int& C) { const int st = b / 1024, sb = b % 1024, swz = sb ^ (((sb >> 9) & 1) << 5); R = (st >> 1) * 16 + swz / 64; C = (st & 1) * 32 + (swz % 64) / 2; }
__host__ __device__ __forceinline__ int perm32(int rho) { const int n = rho >> 4, i = rho & 15; return 8 * (i >> 2) + 4 * n + (i & 3); }

struct Unit { int pm, pn; };
struct Gemm { const bf16_t* A; const bf16_t* Bt; int M, N, K; };

struct StaticOrder {
    int nM, nN, nwg, G, c;
    __host__ __device__ void init(int M, int N, int G_, int c_) { nM = M / BM; nN = N / BM; nwg = nM * nN; G = G_; c = c_; }
    __host__ __device__ bool next(int i, Unit& u) const {
        const long L = (long)i * G + c; if (L >= nwg) return false;
        int wgid = (int)L; { const int q = nwg / NXCD, r = nwg % NXCD, xcd = wgid % NXCD, off = wgid / NXCD; wgid = (xcd < r ? xcd * (q + 1) : r * (q + 1) + (xcd - r) * q) + off; }
        const int nig = WGM * nN, gid = wgid / nig, fm = gid * WGM, gsz = (nM - fm) < WGM ? (nM - fm) : WGM;
        u.pm = fm + ((wgid % nig) % gsz); u.pn = (wgid % nig) / gsz; return true;
    }
    __device__ __forceinline__ void a_ready(const Unit&) const {}
    __device__ __forceinline__ void done(const Unit&) const {}
};

typedef float cvt_f32x2 __attribute__((ext_vector_type(2)));
typedef __bf16 cvt_bf16x2 __attribute__((ext_vector_type(2)));
__device__ __forceinline__ unsigned cvt_pk_bf16(float lo, float hi) { const cvt_f32x2 v = {lo, hi}; const cvt_bf16x2 b = __builtin_convertvector(v, cvt_bf16x2); return __builtin_bit_cast(unsigned, b); }

#ifdef DBG_FLAGS
#define PG_CHK(dbgp, v, bit) do {} while (0)
#else
#define PG_CHK(dbgp, v, bit) do {} while (0)
#endif
__device__ __forceinline__ float row_rstd(const float* SS, int row, int fq) {
    const f32x4 v = *(const f32x4*)(SS + (size_t)row * 16 + 4 * fq);
    float s = (v[0] + v[1]) + (v[2] + v[3]);
    s += __shfl_xor(s, 16); s += __shfl_xor(s, 32);
    return rsqrtf(s * (1.0f / 1024.0f) + 1e-6f);
}
struct EpiP {
    static constexpr bool PERM = true, AFTER_DRAIN = false;
    bf16_t* O; int ldc; const float* SS; const float* bias; int bias_ld;
    __device__ __forceinline__ void operator()(const f32x4 (&acc)[2][2][4][2], const Unit& u, int wr, int wc, int fr, int fq) const {
        const int row0 = u.pm * BM + wr * 64 + fr, col0 = u.pn * BM + wc * 32 + 8 * fq;
        const float* bp = bias + (size_t)(u.pm >> 4) * bias_ld + col0;
        f32x4 bv[2][2];
#pragma unroll
        for (int bj = 0; bj < 2; ++bj)
#pragma unroll
            for (int n = 0; n < 2; ++n) bv[bj][n] = *(const f32x4*)(bp + bj * HALF + 4 * n);
        float rsv[2][4];
        { f32x4 sv[2][4];
#pragma unroll
          for (int ai = 0; ai < 2; ++ai)
#pragma unroll
              for (int m = 0; m < 4; ++m) sv[ai][m] = *(const f32x4*)(SS + (size_t)(row0 + ai * HALF + m * 16) * 16 + 4 * fq);
          __builtin_amdgcn_sched_barrier(0);
#pragma unroll
          for (int ai = 0; ai < 2; ++ai)
#pragma unroll
              for (int m = 0; m < 4; ++m) { float t = (sv[ai][m][0] + sv[ai][m][1]) + (sv[ai][m][2] + sv[ai][m][3]); t += __shfl_xor(t, 16); t += __shfl_xor(t, 32); rsv[ai][m] = rsqrtf(t * (1.0f / 1024.0f) + 1e-6f); } }
#pragma unroll
        for (int ai = 0; ai < 2; ++ai)
#pragma unroll
            for (int m = 0; m < 4; ++m) { const int row = row0 + ai * HALF + m * 16; const float rs = rsv[ai][m];
                bf16_t* rowp = O + (size_t)row * ldc + col0;
#pragma unroll
                for (int bj = 0; bj < 2; ++bj) { const f32x4 v0 = acc[ai][bj][m][0] * rs + bv[bj][0], v1 = acc[ai][bj][m][1] * rs + bv[bj][1];
                    u32x4 w; w.x = cvt_pk_bf16(v0[0], v0[1]); w.y = cvt_pk_bf16(v0[2], v0[3]); w.z = cvt_pk_bf16(v1[0], v1[1]); w.w = cvt_pk_bf16(v1[2], v1[3]);
                    *(u32x4*)(rowp + bj * HALF) = w; } }
    }
};
struct EpiRes {
    static constexpr bool PERM = true, AFTER_DRAIN = false;
    const float* xin32; const bf16_t* xin16; bf16_t* xout; const float* gate; const float* gmul; const float* gsc; bf16_t* Hn; float* SS;
    __device__ __forceinline__ void operator()(const f32x4 (&acc)[2][2][4][2], const Unit& u, int wr, int wc, int fr, int fq) const {
        const int row0 = u.pm * BM + wr * 64 + fr, col0 = u.pn * BM + wc * 32 + 8 * fq;
        const float* gp = gate + (size_t)(u.pm >> 4) * 6144 + col0;
        const float* sp_ = gsc + (size_t)(u.pm >> 4) * 6144 + col0;
        const bool emit = gmul != nullptr, in16 = xin16 != nullptr;
        f32x4 gv[2][2], gm[2][2];
#pragma unroll
        for (int bj = 0; bj < 2; ++bj)
#pragma unroll
            for (int n = 0; n < 2; ++n) { const int co = bj * HALF + 4 * n; gv[bj][n] = *(const f32x4*)(gp + co);
                gm[bj][n] = emit ? *(const f32x4*)(gmul + col0 + co) * (*(const f32x4*)(sp_ + co) + 1.0f) : (f32x4){0.f, 0.f, 0.f, 0.f}; }
        u32x4 xb[2][2];
        if (in16) {
#pragma unroll
            for (int bj = 0; bj < 2; ++bj) xb[0][bj] = *(const u32x4*)(xin16 + (size_t)row0 * 1024 + col0 + bj * HALF); }
#pragma unroll
        for (int it = 0; it < 8; ++it) { const int ai = it >> 2, m = it & 3, row = row0 + ai * HALF + m * 16; const size_t off = (size_t)row * 1024 + col0;
            f32x4 xf[2][2];
            if (in16) {
                if (it < 7) { const size_t offn = (size_t)(row0 + ((it + 1) >> 2) * HALF + ((it + 1) & 3) * 16) * 1024 + col0;
#pragma unroll
                    for (int bj = 0; bj < 2; ++bj) xb[(it + 1) & 1][bj] = *(const u32x4*)(xin16 + offn + bj * HALF); }
#pragma unroll
                for (int bj = 0; bj < 2; ++bj) { const u32x4 w = xb[it & 1][bj];
                    xf[bj][0] = (f32x4){__builtin_bit_cast(float, w.x << 16), __builtin_bit_cast(float, w.x & 0xffff0000u), __builtin_bit_cast(float, w.y << 16), __builtin_bit_cast(float, w.y & 0xffff0000u)};
                    xf[bj][1] = (f32x4){__builtin_bit_cast(float, w.z << 16), __builtin_bit_cast(float, w.z & 0xffff0000u), __builtin_bit_cast(float, w.w << 16), __builtin_bit_cast(float, w.w & 0xffff0000u)}; }
            } else {
#pragma unroll
                for (int bj = 0; bj < 2; ++bj)
#pragma unroll
                    for (int n = 0; n < 2; ++n) xf[bj][n] = *(const f32x4*)(xin32 + off + bj * HALF + 4 * n);
            }
            float ss = 0.f;
#pragma unroll
            for (int bj = 0; bj < 2; ++bj) { const f32x4 x0 = xf[bj][0] + gv[bj][0] * acc[ai][bj][m][0], x1 = xf[bj][1] + gv[bj][1] * acc[ai][bj][m][1];
                u32x4 w; w.x = cvt_pk_bf16(x0[0], x0[1]); w.y = cvt_pk_bf16(x0[2], x0[3]); w.z = cvt_pk_bf16(x1[0], x1[1]); w.w = cvt_pk_bf16(x1[2], x1[3]);
                *(u32x4*)(xout + off + bj * HALF) = w;
                if (emit) { const f32x4 h0 = x0 * gm[bj][0], h1 = x1 * gm[bj][1];
                    ss += ((x0[0] * x0[0] + x0[1] * x0[1]) + (x0[2] * x0[2] + x0[3] * x0[3])) + ((x1[0] * x1[0] + x1[1] * x1[1]) + (x1[2] * x1[2] + x1[3] * x1[3]));
                    u32x4 hw; hw.x = cvt_pk_bf16(h0[0], h0[1]); hw.y = cvt_pk_bf16(h0[2], h0[3]); hw.z = cvt_pk_bf16(h1[0], h1[1]); hw.w = cvt_pk_bf16(h1[2], h1[3]);
                    *(u32x4*)(Hn + off + bj * HALF) = hw; } }
            if (emit) { ss += __shfl_xor(ss, 16); ss += __shfl_xor(ss, 32); if (fq == 0) SS[(size_t)row * 16 + u.pn * 4 + wc] = ss; }
            __builtin_amdgcn_sched_barrier(0); }
    }
};
struct EpiSwiGLU {
    static constexpr bool PERM = true, AFTER_DRAIN = false;
    bf16_t* O; const float* SS; const float* bias;
    __device__ __forceinline__ void operator()(const f32x4 (&acc)[2][2][4][2], const Unit& u, int wr, int wc, int fr, int fq) const {
        const int row0 = u.pm * BM + wr * 64 + fr, col0 = u.pn * HALF + wc * 32 + 8 * fq;
        const float* bp = bias + (size_t)(u.pm >> 4) * 5632 + u.pn * BM + wc * 32 + 8 * fq;
        f32x4 bv[2][2];
#pragma unroll
        for (int bj = 0; bj < 2; ++bj)
#pragma unroll
            for (int n = 0; n < 2; ++n) bv[bj][n] = *(const f32x4*)(bp + bj * HALF + 4 * n);
        float rsv[2][4];
        { f32x4 sv[2][4];
#pragma unroll
          for (int ai = 0; ai < 2; ++ai)
#pragma unroll
              for (int m = 0; m < 4; ++m) sv[ai][m] = *(const f32x4*)(SS + (size_t)(row0 + ai * HALF + m * 16) * 16 + 4 * fq);
          __builtin_amdgcn_sched_barrier(0);
#pragma unroll
          for (int ai = 0; ai < 2; ++ai)
#pragma unroll
              for (int m = 0; m < 4; ++m) { float t = (sv[ai][m][0] + sv[ai][m][1]) + (sv[ai][m][2] + sv[ai][m][3]); t += __shfl_xor(t, 16); t += __shfl_xor(t, 32); rsv[ai][m] = rsqrtf(t * (1.0f / 1024.0f) + 1e-6f); } }
#pragma unroll
        for (int ai = 0; ai < 2; ++ai)
#pragma unroll
            for (int m = 0; m < 4; ++m) { const int row = row0 + ai * HALF + m * 16; const float rs = rsv[ai][m];
                bf16_t* rowp = O + (size_t)row * 2816 + col0;
                float r[8];
#pragma unroll
                for (int n = 0; n < 2; ++n)
#pragma unroll
                    for (int j = 0; j < 4; ++j) { const float g = acc[ai][0][m][n][j] * rs + bv[0][n][j], up = acc[ai][1][m][n][j] * rs + bv[1][n][j];
                        r[4 * n + j] = g * __builtin_amdgcn_rcpf(1.0f + __expf(-g)) * up; }
                u32x4 w; w.x = cvt_pk_bf16(r[0], r[1]); w.y = cvt_pk_bf16(r[2], r[3]); w.z = cvt_pk_bf16(r[4], r[5]); w.w = cvt_pk_bf16(r[6], r[7]);
                *(u32x4*)rowp = w; }
    }
};
template <class Epi, class Sched, bool ALIGN_EPI = false, bool SP2 = false>
__device__ __forceinline__ void gemm_phase(PG8_LAS unsigned char* lds, const Gemm g, const Sched& S, const Epi& E) {
    int tid_ = threadIdx.x; asm volatile("" : "+v"(tid_));
    const int tid = tid_, wid = __builtin_amdgcn_readfirstlane(tid >> 6), lane = tid & 63, wr = wid >> 2, wc = wid & 3, fr = lane & 15, fq = lane >> 4;
    const int K = g.K, nt = K / BK;
    unsigned voffA[2], voffB[2];
#pragma unroll
    for (int i = 0; i < 2; ++i) { int R, C; stage_rc(tid * 16 + i * 8192, R, C); const int Rb = Epi::PERM ? ((R & ~31) + perm32(R & 31)) : R;
        voffA[i] = (unsigned)(R * K + C) * 2u; voffB[i] = (unsigned)(Rb * K + C) * 2u; }
    const size_t kstep = (size_t)(BK * 2);
    const size_t hstep = (size_t)HALF * K * 2;
    const size_t tstep = 2 * hstep;
    const unsigned ldsw = (unsigned)wid * 1024u;
    const int aoff = lds_byte(wr * 64 + fr, fq * 8), boff = lds_byte(wc * 32 + fr, fq * 8);
#define PG8_SA(b, h) (((b) * 2 + (h)) * HTB)
#define PG8_SB(b, h) ((4 + (b) * 2 + (h)) * HTB)
#define PG8_STAGE(bufoff, gbase, voff) do { _Pragma("unroll") for (int _i = 0; _i < 2; ++_i) \
        __builtin_amdgcn_global_load_lds((const unsigned*)((const char*)(gbase) + (voff)[_i]), (PG8_LAS unsigned*)(lds + (bufoff) + ldsw + _i * 8192), 16, 0, 0); } while (0)
#define PG8_LDA(dst, b, h) do { _Pragma("unroll") for (int m = 0; m < 4; ++m) _Pragma("unroll") for (int k = 0; k < 2; ++k) dst[m][k] = *(const PG8_LAS bf16x8*)(lds + PG8_SA(b, h) + aoff + m * 2048 + k * 1024); } while (0)
#define PG8_LDB(dst, b, h) do { _Pragma("unroll") for (int n = 0; n < 2; ++n) _Pragma("unroll") for (int k = 0; k < 2; ++k) dst[n][k] = *(const PG8_LAS bf16x8*)(lds + PG8_SB(b, h) + boff + n * 2048 + k * 1024); } while (0)
#define PG8_MMA(ai, bj, At, Bt) do { __builtin_amdgcn_s_setprio(1); _Pragma("unroll") for (int m = 0; m < 4; ++m) _Pragma("unroll") for (int n = 0; n < 2; ++n) _Pragma("unroll") for (int k = 0; k < 2; ++k) \
        acc[ai][bj][m][n] = __builtin_amdgcn_mfma_f32_16x16x32_bf16(Bt[n][k], At[m][k], acc[ai][bj][m][n], 0, 0, 0); __builtin_amdgcn_s_setprio(0); } while (0)
#define PG8_WAIT_V(n) asm volatile("s_waitcnt vmcnt(" #n ")" ::: "memory")
#define PG8_WAIT_L(n) asm volatile("s_waitcnt lgkmcnt(" #n ")" ::: "memory")
#define PG8_BAR __builtin_amdgcn_s_barrier()
#define PG8_SCHED __builtin_amdgcn_sched_barrier(0)
    Unit cur, nxt; int ui = 0;
    if (!S.next(0, cur)) return;
    f32x4 acc[2][2][4][2];
#pragma unroll
    for (int a = 0; a < 2; ++a)
#pragma unroll
        for (int b = 0; b < 2; ++b)
#pragma unroll
            for (int m = 0; m < 4; ++m)
#pragma unroll
                for (int n = 0; n < 2; ++n) acc[a][b][m][n] = (f32x4){0.f, 0.f, 0.f, 0.f};
    bf16x8 At[4][2], B0[2][2], B1[2][2];
    const char* cA = (const char*)g.A + (size_t)cur.pm * tstep; const char* cB = (const char*)g.Bt + (size_t)cur.pn * tstep;
    S.a_ready(cur);
    if constexpr (SP2) {
        PG8_STAGE(PG8_SB(0, 0), cB, voffB); PG8_STAGE(PG8_SB(0, 1), cB + hstep, voffB); PG8_STAGE(PG8_SA(0, 0), cA, voffA); PG8_STAGE(PG8_SA(0, 1), cA + hstep, voffA);
        if (wr == 1) PG8_BAR;
        PG8_WAIT_V(2); PG8_BAR;
        PG8_STAGE(PG8_SB(1, 0), cB + kstep, voffB); PG8_STAGE(PG8_SA(1, 0), cA + kstep, voffA); PG8_STAGE(PG8_SB(1, 1), cB + hstep + kstep, voffB);
        PG8_WAIT_V(6); PG8_BAR;
    } else {
        PG8_STAGE(PG8_SB(0, 0), cB, voffB); PG8_STAGE(PG8_SA(0, 0), cA, voffA); PG8_STAGE(PG8_SB(0, 1), cB + hstep, voffB); PG8_STAGE(PG8_SA(0, 1), cA + hstep, voffA);
        if (wr == 1) PG8_BAR;
        PG8_WAIT_V(4); PG8_BAR;
        PG8_STAGE(PG8_SB(1, 0), cB + kstep, voffB); PG8_STAGE(PG8_SA(1, 0), cA + kstep, voffA); PG8_STAGE(PG8_SB(1, 1), cB + hstep + kstep, voffB);
        PG8_WAIT_V(6); PG8_BAR;
    }
    for (;;) {
        const bool has_next = S.next(ui + 1, nxt);
        const char* nA = has_next ? (const char*)g.A + (size_t)nxt.pm * tstep : cA; const char* nB = has_next ? (const char*)g.Bt + (size_t)nxt.pn * tstep : cB;
        for (int t = 0; t < nt; t += 2) {
            const bool last = (t == nt - 2);
            const char* a1 = cA + (size_t)(t + 1) * kstep;
            const char* a2 = last ? nA : cA + (size_t)(t + 2) * kstep; const char* b2 = last ? nB : cB + (size_t)(t + 2) * kstep;
            const char* a3 = a2 + kstep; const char* b3 = b2 + kstep;
            if (last && has_next) S.a_ready(nxt);
            if constexpr (SP2) {
            PG8_LDB(B0, 0, 0); PG8_LDB(B1, 0, 1); PG8_SCHED; PG8_LDA(At, 0, 0); PG8_STAGE(PG8_SA(1, 1), a1 + hstep, voffA);
            PG8_WAIT_V(8); PG8_WAIT_L(0); PG8_BAR; PG8_MMA(0, 0, At, B0); PG8_MMA(0, 1, At, B1); PG8_BAR; PG8_SCHED;
            PG8_LDA(At, 0, 1); PG8_STAGE(PG8_SB(0, 0), b2, voffB); PG8_STAGE(PG8_SB(0, 1), b2 + hstep, voffB); PG8_STAGE(PG8_SA(0, 0), a2, voffA);
            PG8_WAIT_V(8); PG8_WAIT_L(0); PG8_BAR; PG8_MMA(1, 0, At, B0); PG8_MMA(1, 1, At, B1); PG8_BAR; PG8_SCHED;
            PG8_LDB(B0, 1, 0); PG8_LDB(B1, 1, 1); PG8_SCHED; PG8_LDA(At, 1, 0); PG8_STAGE(PG8_SA(0, 1), a2 + hstep, voffA);
            PG8_WAIT_V(8); PG8_WAIT_L(0); PG8_BAR; PG8_MMA(0, 0, At, B0); PG8_MMA(0, 1, At, B1); PG8_BAR; PG8_SCHED;
            PG8_LDA(At, 1, 1); PG8_STAGE(PG8_SB(1, 0), b3, voffB); PG8_STAGE(PG8_SB(1, 1), b3 + hstep, voffB); PG8_STAGE(PG8_SA(1, 0), a3, voffA);
            PG8_WAIT_V(8); PG8_WAIT_L(0); PG8_BAR; PG8_MMA(1, 0, At, B0); PG8_MMA(1, 1, At, B1); PG8_BAR; PG8_SCHED;
            } else {
            PG8_LDB(B0, 0, 0); PG8_SCHED; PG8_LDA(At, 0, 0); PG8_STAGE(PG8_SA(1, 1), a1 + hstep, voffA);
            PG8_WAIT_L(8); PG8_BAR; PG8_WAIT_L(0); PG8_MMA(0, 0, At, B0); PG8_BAR; PG8_SCHED;
            PG8_LDB(B1, 0, 1); PG8_STAGE(PG8_SB(0, 0), b2, voffB);
            PG8_BAR; PG8_WAIT_L(0); PG8_MMA(0, 1, At, B1); PG8_BAR;
            PG8_LDA(At, 0, 1); PG8_STAGE(PG8_SA(0, 0), a2, voffA);
            PG8_BAR; PG8_WAIT_L(0); PG8_MMA(1, 0, At, B0); PG8_BAR; PG8_SCHED;
            PG8_STAGE(PG8_SB(0, 1), b2 + hstep, voffB);
            PG8_WAIT_V(6); PG8_BAR; PG8_MMA(1, 1, At, B1); PG8_BAR;
            PG8_LDB(B0, 1, 0); PG8_SCHED; PG8_LDA(At, 1, 0); PG8_STAGE(PG8_SA(0, 1), a2 + hstep, voffA);
            PG8_WAIT_L(8); PG8_BAR; PG8_WAIT_L(0); PG8_MMA(0, 0, At, B0); PG8_BAR; PG8_SCHED;
            PG8_LDB(B1, 1, 1); PG8_STAGE(PG8_SB(1, 0), b3, voffB);
            PG8_BAR; PG8_WAIT_L(0); PG8_MMA(0, 1, At, B1); PG8_BAR;
            PG8_LDA(At, 1, 1); PG8_STAGE(PG8_SA(1, 0), a3, voffA);
            PG8_BAR; PG8_WAIT_L(0); PG8_MMA(1, 0, At, B0); PG8_BAR; PG8_SCHED;
            PG8_STAGE(PG8_SB(1, 1), b3 + hstep, voffB);
            PG8_WAIT_V(6); PG8_BAR; PG8_MMA(1, 1, At, B1); PG8_BAR;
            }
        }
        if constexpr (ALIGN_EPI) { if (wr == 0) PG8_BAR; }
        if constexpr (!Epi::AFTER_DRAIN) { E(acc, cur, wr, wc, fr, fq); S.done(cur); }
        if (!has_next) break;
#pragma unroll
        for (int a = 0; a < 2; ++a)
#pragma unroll
            for (int b = 0; b < 2; ++b)
#pragma unroll
                for (int m = 0; m < 4; ++m)
#pragma unroll
                    for (int n = 0; n < 2; ++n) acc[a][b][m][n] = (f32x4){0.f, 0.f, 0.f, 0.f};
        cur = nxt; cA = nA; cB = nB; ++ui;
        if constexpr (ALIGN_EPI) { if (wr == 1) PG8_BAR; }
    }
    PG8_WAIT_V(0);
    if constexpr (!ALIGN_EPI) { if (wr == 0) PG8_BAR; }
    PG8_BAR;
    if constexpr (Epi::AFTER_DRAIN) { E.fused(acc, cur, wr, wc, fr, fq, lds, wid, lane); S.done(cur); }
#undef PG8_SA
#undef PG8_SB
#undef PG8_STAGE
#undef PG8_LDA
#undef PG8_LDB
#undef PG8_MMA
#undef PG8_WAIT_V
#undef PG8_WAIT_L
#undef PG8_BAR
#undef PG8_SCHED
}
}


#define LAS __attribute__((address_space(3)))
typedef unsigned short bf16;
typedef float f32x4 __attribute__((ext_vector_type(4)));
typedef short bf16x8 __attribute__((ext_vector_type(8)));
typedef unsigned u32x4 __attribute__((ext_vector_type(4)));
typedef unsigned u32x2 __attribute__((ext_vector_type(2)));

constexpr int T = 65536, DM = 1024, SEQ = 4096, NBATCH = 16, DIN = 2176, DINP = 2304, DFF = 2816, DEPTH = 4, DLRU = 384;
constexpr int NTHR = 512, NWAVES = 8;
constexpr int LDS_BYTES = 155648;
constexpr size_t MiB = 1u << 20;
constexpr size_t WS_WIN = 0;
constexpr size_t WS_WOUT = 18 * MiB;
constexpr size_t WS_WGU = 26 * MiB;
constexpr size_t WS_WDN = 70 * MiB;
constexpr size_t WS_WLRU = 92 * MiB;
constexpr size_t WS_WF = 93 * MiB;
constexpr size_t WS_MOD = 94 * MiB;
constexpr size_t WS_MODP = 96 * MiB;
constexpr size_t WS_CAR = 122 * MiB;
constexpr size_t WS_HIN = 128 * MiB;
constexpr size_t WS_H = 132 * MiB;
constexpr size_t WS_P = 260 * MiB;
constexpr size_t WS_Y = 548 * MiB;
constexpr size_t WS_HID = 260 * MiB;
constexpr size_t WS_BAR = 131 * MiB;
constexpr size_t WS_SS = 676 * MiB;
constexpr size_t WS_BIN = 680 * MiB;
constexpr size_t WS_BGU = 681 * MiB;
constexpr size_t WS_XB = 683 * MiB;
constexpr size_t WS_END = 811 * MiB;

struct Args { const float* in[21]; float* out; unsigned char* ws; };
constexpr size_t WS_DBG = 131 * MiB + 512 * 1024;
#ifdef DBG_FLAGS
#define DBG_CHK(dbgp, v, bit) do {} while (0)
#define DBG2(dbgp, v, bit) do { if ((dbgp) && !(fabsf(v) < 1e30f)) atomicOr((dbgp), 1u << (bit)); } while (0)
#else
#define DBG2(dbgp, v, bit) do {} while (0)
#define DBG_CHK(dbgp, v, bit) do {} while (0)
#endif

__device__ __forceinline__ float bflo(unsigned w) { return __uint_as_float(w << 16); }
__device__ __forceinline__ float bfhi(unsigned w) { return __uint_as_float(w & 0xffff0000u); }
__device__ __forceinline__ unsigned pk2(float lo, float hi) { return pg8::cvt_pk_bf16(lo, hi); }
__device__ __forceinline__ u32x2 pk4(f32x4 v) { u32x2 r; r.x = pk2(v[0], v[1]); r.y = pk2(v[2], v[3]); return r; }
__device__ __forceinline__ f32x4 mfma16(bf16x8 a, bf16x8 b, f32x4 c) { return __builtin_amdgcn_mfma_f32_16x16x32_bf16(a, b, c, 0, 0, 0); }
__device__ __forceinline__ float wave_sum(float v) {
#pragma unroll
    for (int o = 1; o < 64; o <<= 1) v += __shfl_xor(v, o);
    return v;
}
__device__ __forceinline__ float sigmoidf_(float x) { return __builtin_amdgcn_rcpf(1.0f + __expf(-x)); }
#define LDS_FRAG(p) (*(const LAS bf16x8*)(p))
#define LDS_BARRIER() do { asm volatile("s_waitcnt lgkmcnt(0)" ::: "memory"); __builtin_amdgcn_s_barrier(); asm volatile("" ::: "memory"); } while (0)

__device__ __forceinline__ void tr_item(const float* W, int K, int N, bf16* WT, int dst_row0, float scale, LAS float* scr, int kb, int nb, int lane) {
    const int k0 = 64 * kb, n0 = 32 * nb;
#pragma unroll 8
    for (int i = 0; i < 32; ++i) { const int kk = 2 * i + (lane >> 5); scr[kk * 33 + (lane & 31)] = W[(size_t)(k0 + kk) * N + n0 + (lane & 31)] * scale; }
    asm volatile("s_waitcnt lgkmcnt(0)" ::: "memory");
    const int c = lane & 7;
#pragma unroll
    for (int j = 0; j < 4; ++j) { const int n = (lane >> 3) + 8 * j; const LAS float* s = scr + (8 * c) * 33 + n;
        u32x4 o; o.x = pk2(s[0 * 33], s[1 * 33]); o.y = pk2(s[2 * 33], s[3 * 33]); o.z = pk2(s[4 * 33], s[5 * 33]); o.w = pk2(s[6 * 33], s[7 * 33]);
        *(u32x4*)(WT + (size_t)(dst_row0 + n) * K + k0 + 8 * c) = o; }
    asm volatile("s_waitcnt lgkmcnt(0)" ::: "memory");
}

__device__ __forceinline__ void phase_prologue_a(const Args& a, LAS unsigned char* lds, int tid, int wave, int lane, int G) {
    unsigned char* ws = a.ws;
    LAS float* cact = (LAS float*)lds;
    for (int i = tid; i < NBATCH * DM; i += NTHR) { const float c = a.in[1][i]; cact[i] = c * sigmoidf_(c); }
    __syncthreads();
    LAS float* scr = (LAS float*)(lds + 65536 + wave * 8448);
    const int gw = blockIdx.x * NWAVES + wave, NGW = G * NWAVES;
    constexpr int I_IN = 16 * 68, I_OUT = 16 * 32, I_G = 16 * 88, I_DN = 44 * 32, I_LRU = 24, I_F = 8;
    constexpr int PER_L = I_IN + I_OUT + 2 * I_G + I_DN + 2 * I_LRU + I_F;
    constexpr int N_TR = DEPTH * PER_L, N_MODP = DEPTH * 24 * 16;
    for (int it = gw; it < N_TR + N_MODP; it += NGW) {
        if (it < N_TR) {
            const int l = it / PER_L; int r = it % PER_L;
            if (r < I_IN) { const int kb = r / 68, nb = r % 68; const float sc = (nb >= 32 && nb < 44) ? 0.125f * 1.4426950408889634f : 1.0f;
                tr_item(a.in[6] + (size_t)l * DM * DIN, DM, DIN, (bf16*)(ws + WS_WIN) + (size_t)l * DINP * DM, 32 * nb, sc, scr, kb, nb, lane); continue; } r -= I_IN;
            if (r < I_OUT) { const int kb = r / 32, nb = r % 32;
                tr_item(a.in[16] + (size_t)l * DM * DM, DM, DM, (bf16*)(ws + WS_WOUT) + (size_t)l * DM * DM, 32 * nb, 1.0f, scr, kb, nb, lane); continue; } r -= I_OUT;
            if (r < 2 * I_G) { const int up = r >= I_G; if (up) r -= I_G; const int kb = r / 88, nb = r % 88; const int n0 = 32 * nb;
                tr_item(a.in[up ? 18 : 17] + (size_t)l * DM * DFF, DM, DFF, (bf16*)(ws + WS_WGU) + (size_t)l * 5632 * DM, 256 * (n0 >> 7) + 128 * up + (n0 & 127), 1.0f, scr, kb, nb, lane); continue; } r -= 2 * I_G;
            if (r < I_DN) { const int kb = r / 32, nb = r % 32;
                tr_item(a.in[19] + (size_t)l * DFF * DM, DFF, DM, (bf16*)(ws + WS_WDN) + (size_t)l * DM * DFF, 32 * nb, 1.0f, scr, kb, nb, lane); continue; } r -= I_DN;
            if (r < 2 * I_LRU) { const int gate = r >= I_LRU; if (gate) r -= I_LRU; const int mat = r >> 1, nb = r & 1;
                const int dir = mat / 6, h = mat % 6;
                tr_item(a.in[gate ? 12 : 10] + (size_t)((l * 2 + dir) * 6 + h) * 4096, 64, 64, (bf16*)(ws + WS_WLRU) + (size_t)((((l * 2 + dir) * 2 + gate) * 6) + h) * 4096, 32 * nb, -1.4426950408889634f, scr, 0, nb, lane); continue; } r -= 2 * I_LRU;
            { const int g = r >> 1, nb = r & 1;
                tr_item(a.in[7] + (size_t)(l * 4 + g) * 4096, 64, 64, (bf16*)(ws + WS_WF) + (size_t)(l * 4 + g) * 4096, 32 * nb, 1.0f, scr, 0, nb, lane); }
        } else {
            const int m = it - N_TR; const int ks = m & 15, cb = (m >> 4) % 24, l = (m >> 4) / 24;
            const int c0 = cb * 256 + lane * 4;
            f32x4 acc[16];
#pragma unroll
            for (int b = 0; b < 16; ++b) acc[b] = (f32x4){0.f, 0.f, 0.f, 0.f};
            const float* wp = a.in[2] + ((size_t)l * DM + ks * 64) * 6144 + c0;
#pragma unroll 4
            for (int kk = 0; kk < 64; ++kk) { const f32x4 w = *(const f32x4*)(wp + (size_t)kk * 6144);
#pragma unroll
                for (int b = 0; b < 16; ++b) { const float ca = cact[b * DM + ks * 64 + kk]; acc[b] += w * ca; } }
            float* mp = (float*)(ws + WS_MODP) + ((size_t)(ks * 64 + l * 16)) * 6144 + c0;
#pragma unroll
            for (int b = 0; b < 16; ++b) *(f32x4*)(mp + (size_t)b * 6144) = acc[b];
        }
    }
    const int gt = blockIdx.x * NTHR + tid, NGT = G * NTHR;
    for (int i = gt; i < DEPTH * 128 * DM / 8; i += NGT) { const int l = i / (128 * DM / 8), o = i % (128 * DM / 8);
        *(u32x4*)((bf16*)(ws + WS_WIN) + (size_t)l * DINP * DM + (size_t)DIN * DM + (size_t)o * 8) = (u32x4){0u, 0u, 0u, 0u}; }
}
__device__ __forceinline__ void phase_prologue_b(const Args& a, int tid, int G) {
    const int gt = blockIdx.x * NTHR + tid, NGT = G * NTHR;
    for (int i = gt; i < DEPTH * NBATCH * 6144 / 4; i += NGT) { const int flat = i * 4, j = flat % 6144, lb = flat / 6144, l = lb >> 4;
        f32x4 s = *(const f32x4*)(a.in[3] + l * 6144 + j);
#pragma unroll
        for (int ks = 0; ks < 16; ++ks) s += *(const f32x4*)((const float*)(a.ws + WS_MODP) + ((size_t)(ks * 64 + lb)) * 6144 + j);
        *(f32x4*)((float*)(a.ws + WS_MOD) + (size_t)lb * 6144 + j) = s; }
}

__device__ __forceinline__ void phase_norm(const float* xin, const float* g, const float* modl, int sh_off, int sc_off, bf16* H, int wave, int lane, int G, unsigned* dbg) {
    const int gw = blockIdx.x * NWAVES + wave, NGW = G * NWAVES;
    for (int m = gw; m < T; m += NGW) {
        const int b = m >> 12;
        const f32x4* xr = (const f32x4*)(xin + (size_t)m * DM) + lane;
        f32x4 v[4]; float ss = 0.f;
#pragma unroll
        for (int j = 0; j < 4; ++j) { v[j] = xr[64 * j]; ss += (v[j][0] * v[j][0] + v[j][1] * v[j][1]) + (v[j][2] * v[j][2] + v[j][3] * v[j][3]); }
        const float rstd = rsqrtf(wave_sum(ss) * (1.0f / DM) + 1e-6f);
        u32x2* o8 = (u32x2*)(H + (size_t)m * DM) + lane;
#pragma unroll
        for (int j = 0; j < 4; ++j) { const int col = 4 * lane + 256 * j;
            const f32x4 gv = *(const f32x4*)(g + col), sc = *(const f32x4*)(modl + b * 6144 + sc_off + col), sh = *(const f32x4*)(modl + b * 6144 + sh_off + col);
            const f32x4 y = v[j] * rstd * gv * (sc + 1.0f) + sh;
            for (int q = 0; q < 4; ++q) DBG_CHK(dbg, y[q], 0);
            o8[64 * j] = pk4(y); }
    }
}
__device__ __forceinline__ void phase_final_norm(const bf16* xb, float* out, const float* g, int wave, int lane, int G) {
    const int gw = blockIdx.x * NWAVES + wave, NGW = G * NWAVES;
    for (int m = gw; m < T; m += NGW) {
        const u32x4* xr = (const u32x4*)(xb + (size_t)m * DM) + lane;
        f32x4 v[2][2]; float ss = 0.f;
#pragma unroll
        for (int j = 0; j < 2; ++j) { const u32x4 w = xr[64 * j];
            v[j][0] = (f32x4){bflo(w.x), bfhi(w.x), bflo(w.y), bfhi(w.y)}; v[j][1] = (f32x4){bflo(w.z), bfhi(w.z), bflo(w.w), bfhi(w.w)};
#pragma unroll
            for (int n = 0; n < 2; ++n) ss += (v[j][n][0] * v[j][n][0] + v[j][n][1] * v[j][n][1]) + (v[j][n][2] * v[j][n][2] + v[j][n][3] * v[j][n][3]); }
        const float rstd = rsqrtf(wave_sum(ss) * (1.0f / DM) + 1e-6f);
        float* orow = out + (size_t)m * DM + 8 * lane;
#pragma unroll
        for (int j = 0; j < 2; ++j)
#pragma unroll
            for (int n = 0; n < 2; ++n) { const f32x4 gv = *(const f32x4*)(g + 8 * lane + 512 * j + 4 * n); *(f32x4*)(orow + 512 * j + 4 * n) = v[j][n] * rstd * gv; }
    }
}
__device__ __forceinline__ void phase_xt0(const float* xin, const float* g, const float* modl, int sc_off, bf16* H, float* SS, int wave, int lane, int G) {
    const int gw = blockIdx.x * NWAVES + wave, NGW = G * NWAVES;
    for (int m = gw; m < T; m += NGW) {
        const int b = m >> 12;
        const f32x4* xr = (const f32x4*)(xin + (size_t)m * DM) + lane;
        u32x2* o8 = (u32x2*)(H + (size_t)m * DM) + lane;
        float ss = 0.f;
#pragma unroll
        for (int j = 0; j < 4; ++j) { const f32x4 v = xr[64 * j]; ss += (v[0] * v[0] + v[1] * v[1]) + (v[2] * v[2] + v[3] * v[3]);
            const int col = 4 * lane + 256 * j;
            const f32x4 gv = *(const f32x4*)(g + col), sc = *(const f32x4*)(modl + b * 6144 + sc_off + col);
            o8[64 * j] = pk4(v * gv * (sc + 1.0f)); }
        ss = wave_sum(ss);
        if (lane < 16) SS[(size_t)m * 16 + lane] = (lane == 0) ? ss : 0.f;
    }
}
__device__ __forceinline__ void phase_bias(unsigned char* ws, int wave, int lane, int G) {
    const int gw = blockIdx.x * NWAVES + wave, NGW = G * NWAVES, fr = lane & 15, fq = lane >> 4;
    constexpr int TIN = DINP / 16, TGU = 5632 / 16, PER_L = TIN + TGU;
    for (int it = gw; it < DEPTH * PER_L; it += NGW) {
        const int l = it / PER_L; int r = it % PER_L; const bool gu = r >= TIN; if (gu) r -= TIN;
        const bf16* Wt = gu ? (const bf16*)(ws + WS_WGU) + (size_t)l * 5632 * DM : (const bf16*)(ws + WS_WIN) + (size_t)l * DINP * DM;
        const float* sh = (const float*)(ws + WS_MOD) + (size_t)l * NBATCH * 6144 + (gu ? 3072 : 0) + (size_t)fr * 6144 + 8 * fq;
        const bf16* wp = Wt + (size_t)(16 * r + fr) * DM + 8 * fq;
        f32x4 acc = (f32x4){0.f, 0.f, 0.f, 0.f};
#pragma unroll 4
        for (int ks = 0; ks < 32; ++ks) { const bf16x8 wf = *(const bf16x8*)(wp + 32 * ks);
            const f32x4 s0 = *(const f32x4*)(sh + 32 * ks), s1 = *(const f32x4*)(sh + 32 * ks + 4);
            u32x4 sw; sw.x = pk2(s0[0], s0[1]); sw.y = pk2(s0[2], s0[3]); sw.z = pk2(s1[0], s1[1]); sw.w = pk2(s1[2], s1[3]);
            acc = mfma16(wf, __builtin_bit_cast(bf16x8, sw), acc); }
        float* dst = gu ? (float*)(ws + WS_BGU) + ((size_t)l * NBATCH + fr) * 5632 : (float*)(ws + WS_BIN) + ((size_t)l * NBATCH + fr) * DINP;
        *(f32x4*)(dst + 16 * r + 4 * fq) = acc;
    }
}

constexpr int F_C = 0, F_S = 9216, F_NS = 18432, F_T0 = 27648, F_T1 = 36864, F_T2 = 46080, F_T3 = 55296, F_W = 64512;
__device__ __forceinline__ void build_dft_tables(LAS unsigned char* lds, int tid) {
    for (int i = tid; i < 4096; i += NTHR) { const int r = i >> 6, c = i & 63, m = (r * c) & 63; const float ang = (float)m * (1.0f / 32.0f);
        const float cs = cospif(ang), sn = sinpif(ang);
        const unsigned pc = pk2(cs, sn), pn = pk2(-sn, 0.f);
        *(LAS bf16*)(lds + F_C + r * 144 + c * 2) = (bf16)(pc & 0xffffu);
        *(LAS bf16*)(lds + F_S + r * 144 + c * 2) = (bf16)(pc >> 16);
        *(LAS bf16*)(lds + F_NS + r * 144 + c * 2) = (bf16)(pn & 0xffffu); }
}
__device__ __forceinline__ u32x4 fourier1_load(const bf16* P, int item, int tid) {
    const int s2 = item & 63, bg = item >> 6, g = bg & 3, b = bg >> 2, s1 = tid >> 3, c8 = tid & 7;
    return *(const u32x4*)(P + (size_t)(b * SEQ + 64 * s1 + s2) * DINP + 64 * g + 8 * c8);
}
__device__ __forceinline__ void fourier1_item(LAS unsigned char* lds, u32x4 vpre, bf16* Z2, int item, int tid, int wave, int lane, unsigned* dbg) {
    const int s2 = item & 63, bg = item >> 6, g = bg & 3, b = bg >> 2, fr = lane & 15, fq = lane >> 4;
    { const int s1 = tid >> 3, c8 = tid & 7; *(LAS u32x4*)(lds + F_T0 + s1 * 144 + c8 * 16) = vpre; }
    LDS_BARRIER();
    const int ib = wave >> 1;
    { const bf16x8 x0 = LDS_FRAG(lds + F_T0 + (16 * ib + fr) * 144 + fq * 16), x1 = LDS_FRAG(lds + F_T0 + (16 * ib + fr) * 144 + fq * 16 + 64);
#pragma unroll
      for (int jj = 0; jj < 2; ++jj) { const int jb = 2 * (wave & 1) + jj, off = (16 * jb + fr) * 144 + fq * 16;
          const bf16x8 c0 = LDS_FRAG(lds + F_C + off), c1 = LDS_FRAG(lds + F_C + off + 64), n0 = LDS_FRAG(lds + F_NS + off), n1 = LDS_FRAG(lds + F_NS + off + 64);
          f32x4 aA = mfma16(x0, c0, (f32x4){0.f, 0.f, 0.f, 0.f}); aA = mfma16(x1, c1, aA);
          f32x4 aB = mfma16(x0, n0, (f32x4){0.f, 0.f, 0.f, 0.f}); aB = mfma16(x1, n1, aB);
          for (int q = 0; q < 4; ++q) { DBG2(dbg, aA[q], 1); DBG2(dbg, aB[q], 1); }
          const int so = (16 * jb + fr) * 144 + (16 * ib + 4 * fq) * 2;
          *(LAS u32x2*)(lds + F_T2 + so) = pk4(aA); *(LAS u32x2*)(lds + F_T3 + so) = pk4(aB); } }
    LDS_BARRIER();
    { const int ao = (16 * ib + fr) * 144 + fq * 16;
      const bf16x8 a0 = LDS_FRAG(lds + F_T2 + ao), a1 = LDS_FRAG(lds + F_T2 + ao + 64), b0 = LDS_FRAG(lds + F_T3 + ao), b1 = LDS_FRAG(lds + F_T3 + ao + 64);
#pragma unroll
      for (int jj = 0; jj < 2; ++jj) { const int jb = 2 * (wave & 1) + jj, off = (16 * jb + fr) * 144 + fq * 16;
          const bf16x8 c0 = LDS_FRAG(lds + F_C + off), c1 = LDS_FRAG(lds + F_C + off + 64), s0 = LDS_FRAG(lds + F_S + off), s1 = LDS_FRAG(lds + F_S + off + 64),
                       n0 = LDS_FRAG(lds + F_NS + off), n1 = LDS_FRAG(lds + F_NS + off + 64);
          f32x4 zr = mfma16(a0, c0, (f32x4){0.f, 0.f, 0.f, 0.f}); zr = mfma16(a1, c1, zr); zr = mfma16(b0, s0, zr); zr = mfma16(b1, s1, zr);
          f32x4 zi = mfma16(b0, c0, (f32x4){0.f, 0.f, 0.f, 0.f}); zi = mfma16(b1, c1, zi); zi = mfma16(a0, n0, zi); zi = mfma16(a1, n1, zi);
          for (int q = 0; q < 4; ++q) { DBG2(dbg, zr[q], 2); DBG2(dbg, zi[q], 2); }
          const int k1 = 16 * jb + fr; const float ang = (float)(s2 * k1) * (1.0f / 2048.0f); const float ct = cospif(ang), st = sinpif(ang);
          const f32x4 wr_ = zr * ct + zi * st, wi_ = zi * ct - zr * st;
          for (int q = 0; q < 4; ++q) { DBG2(dbg, wr_[q], 3); DBG2(dbg, wi_[q], 3); }
          bf16* dst = Z2 + ((size_t)((bg * 64 + k1) * 64 + s2)) * 128 + 16 * ib + 4 * fq;
          *(u32x2*)dst = pk4(wr_); *(u32x2*)(dst + 64) = pk4(wi_); } }
}
struct F2Pre { u32x4 re, im, w; };
__device__ __forceinline__ F2Pre fourier2_load(const bf16* Z2, const bf16* WFl, int item, int tid) {
    const int g = (item >> 6) & 3, s2 = tid >> 3, c8 = tid & 7;
    const bf16* src = Z2 + ((size_t)(item * 64 + s2)) * 128 + 8 * c8;
    F2Pre p; p.re = *(const u32x4*)src; p.im = *(const u32x4*)(src + 64); p.w = *(const u32x4*)(WFl + g * 4096 + s2 * 64 + 8 * c8); return p;
}
__device__ __forceinline__ void fourier2_item(LAS unsigned char* lds, const F2Pre pre, bf16* Y, int item, int tid, int wave, int lane, unsigned* dbg) {
    const int k1 = item & 63, bg = item >> 6, g = bg & 3, b = bg >> 2, fr = lane & 15, fq = lane >> 4;
    { const int s2 = tid >> 3, c8 = tid & 7;
      *(LAS u32x4*)(lds + F_T0 + s2 * 144 + c8 * 16) = pre.re; *(LAS u32x4*)(lds + F_T1 + s2 * 144 + c8 * 16) = pre.im; *(LAS u32x4*)(lds + F_W + s2 * 144 + c8 * 16) = pre.w; }
    LDS_BARRIER();
    const int ib = wave >> 1;
    { const int xo = (16 * ib + fr) * 144 + fq * 16;
      const bf16x8 r0 = LDS_FRAG(lds + F_T0 + xo), r1 = LDS_FRAG(lds + F_T0 + xo + 64), i0 = LDS_FRAG(lds + F_T1 + xo), i1 = LDS_FRAG(lds + F_T1 + xo + 64);
#pragma unroll
      for (int jj = 0; jj < 2; ++jj) { const int jb = 2 * (wave & 1) + jj, off = (16 * jb + fr) * 144 + fq * 16;
          const bf16x8 w0 = LDS_FRAG(lds + F_W + off), w1 = LDS_FRAG(lds + F_W + off + 64);
          f32x4 qr = mfma16(r0, w0, (f32x4){0.f, 0.f, 0.f, 0.f}); qr = mfma16(r1, w1, qr);
          f32x4 qi = mfma16(i0, w0, (f32x4){0.f, 0.f, 0.f, 0.f}); qi = mfma16(i1, w1, qi);
          for (int q = 0; q < 4; ++q) { DBG2(dbg, qr[q], 5); DBG2(dbg, qi[q], 5); }
          const int so = (16 * jb + fr) * 144 + (16 * ib + 4 * fq) * 2;
          *(LAS u32x2*)(lds + F_T2 + so) = pk4(qr); *(LAS u32x2*)(lds + F_T3 + so) = pk4(qi); } }
    LDS_BARRIER();
    { const int ao = (16 * ib + fr) * 144 + fq * 16;
      const bf16x8 a0 = LDS_FRAG(lds + F_T2 + ao), a1 = LDS_FRAG(lds + F_T2 + ao + 64), b0 = LDS_FRAG(lds + F_T3 + ao), b1 = LDS_FRAG(lds + F_T3 + ao + 64);
#pragma unroll
      for (int jj = 0; jj < 2; ++jj) { const int jb = 2 * (wave & 1) + jj, off = (16 * jb + fr) * 144 + fq * 16;
          const bf16x8 c0 = LDS_FRAG(lds + F_C + off), c1 = LDS_FRAG(lds + F_C + off + 64), s0 = LDS_FRAG(lds + F_S + off), s1 = LDS_FRAG(lds + F_S + off + 64);
          f32x4 x = mfma16(a0, c0, (f32x4){0.f, 0.f, 0.f, 0.f}); x = mfma16(a1, c1, x); x = mfma16(b0, s0, x); x = mfma16(b1, s1, x);
          const int k2 = 16 * jb + fr;
          for (int q = 0; q < 8; ++q) { DBG2(dbg, bflo((unsigned)(unsigned short)c0[q]), 0); DBG2(dbg, bflo((unsigned)(unsigned short)c1[q]), 0); DBG2(dbg, bflo((unsigned)(unsigned short)s0[q]), 1); DBG2(dbg, bflo((unsigned)(unsigned short)s1[q]), 1);
              DBG2(dbg, bflo((unsigned)(unsigned short)a0[q]), 2); DBG2(dbg, bflo((unsigned)(unsigned short)a1[q]), 2); DBG2(dbg, bflo((unsigned)(unsigned short)b0[q]), 3); DBG2(dbg, bflo((unsigned)(unsigned short)b1[q]), 3); }
          for (int q = 0; q < 4; ++q) DBG2(dbg, x[q], 4);
          *(u32x2*)(Y + (size_t)(b * SEQ + k1 + 64 * k2) * DM + 64 * g + 16 * ib + 4 * fq) = pk4(x * (1.0f / 512.0f)); } }
}

constexpr int L_UB = 0, L_UF = 9216, L_AB = 26624, L_ARR = 17408, L_SEG = 96256;
struct LruPtrs { const bf16* P; const bf16* WL; const float *cw, *cb, *ba, *bx, *lam; float* car; const float* hin; bf16* Y; unsigned* dbg; };
__device__ __forceinline__ float one_minus_exp(float w) {
    const float ser = -w * (1.0f + w * (0.5f + w * (0.16666667f + w * 0.041666668f)));
    return (w > -0.03f) ? ser : 1.0f - __expf(w);
}
template <int PASS> __device__ __forceinline__ void lru_phase(LAS unsigned char* lds, const LruPtrs& q, int l, int tid, int wave, int lane, int G) {
    constexpr int NIT = NBATCH * 64 * 6;
    const int fr = lane & 15, fq = lane >> 4;
    const int ct = tid >> 3, c8 = tid & 7;
    const int gdir = wave >> 2, geb = wave & 3;
    const int e0 = 16 * geb + 4 * fq;
    float cw[4][8], cbv[8];
    bf16x8 wa0, wa1, wx0, wx1; f32x4 ba, bx, sp;
    int hcur = -1;
    u32x4 pxn[4]; u32x4 pgn; float hinn = 0.f;
    const int per_blk = (NIT + G - 1) / G;
    int it = blockIdx.x * per_blk; const int it_end = min(it + per_blk, NIT);
    auto issue = [&](int item) {
        const int h = item >> 10, br = item & 1023, r = br & 63, b = br >> 6;
        const int ch0 = 64 * h + 8 * c8;
#pragma unroll
        for (int k = 0; k < 4; ++k) { const int s = 64 * r + ct + k - 2; const int sc = min(max(s, 0), SEQ - 1);
            pxn[k] = *(const u32x4*)(q.P + (size_t)(b * SEQ + sc) * DINP + 256 + ch0); }
        if (PASS == 2) { pgn = *(const u32x4*)(q.P + (size_t)(b * SEQ + 64 * r + ct) * DINP + 640 + ch0);
            hinn = q.hin[((b * 64 + r) * 2 + (wave >> 2)) * DLRU + 64 * h + lane]; }
    };
    if (it < it_end) issue(it);
    for (; it < it_end; ++it) {
        const int h = it >> 10, br = it & 1023, r = br & 63, b = br >> 6;
        const int t0 = b * SEQ + 64 * r;
        if (h != hcur) { hcur = h;
            const int ch0 = 64 * h + 8 * c8;
#pragma unroll
            for (int k = 0; k < 4; ++k) { const f32x4 w0 = *(const f32x4*)(q.cw + (l * 4 + k) * DLRU + ch0), w1 = *(const f32x4*)(q.cw + (l * 4 + k) * DLRU + ch0 + 4);
                cw[k][0] = w0[0]; cw[k][1] = w0[1]; cw[k][2] = w0[2]; cw[k][3] = w0[3]; cw[k][4] = w1[0]; cw[k][5] = w1[1]; cw[k][6] = w1[2]; cw[k][7] = w1[3]; }
            { const f32x4 c0 = *(const f32x4*)(q.cb + l * DLRU + ch0), c1 = *(const f32x4*)(q.cb + l * DLRU + ch0 + 4);
              cbv[0] = c0[0]; cbv[1] = c0[1]; cbv[2] = c0[2]; cbv[3] = c0[3]; cbv[4] = c1[0]; cbv[5] = c1[1]; cbv[6] = c1[2]; cbv[7] = c1[3]; }
            const bf16* Wa = q.WL + (size_t)((((l * 2 + gdir) * 2 + 0) * 6) + h) * 4096 + (16 * geb + fr) * 64 + 8 * fq;
            const bf16* Wx = q.WL + (size_t)((((l * 2 + gdir) * 2 + 1) * 6) + h) * 4096 + (16 * geb + fr) * 64 + 8 * fq;
            wa0 = *(const bf16x8*)Wa; wa1 = *(const bf16x8*)(Wa + 32); wx0 = *(const bf16x8*)Wx; wx1 = *(const bf16x8*)(Wx + 32);
            const int chg = (l * 2 + gdir) * DLRU + 64 * h + e0;
            ba = *(const f32x4*)(q.ba + chg) * -1.4426950408889634f; bx = *(const f32x4*)(q.bx + chg) * -1.4426950408889634f;
            const f32x4 lam = *(const f32x4*)(q.lam + chg);
#pragma unroll
            for (int j = 0; j < 4; ++j) sp[j] = -8.0f * 1.4426950408889634f * log1pf(expf(-lam[j])); }
        { float u[8];
#pragma unroll
          for (int j = 0; j < 8; ++j) u[j] = cbv[j];
#pragma unroll
          for (int k = 0; k < 4; ++k) { const int sq = 64 * r + ct + k - 2; const bool inb = (sq >= 0) && (sq < SEQ);
              u32x4 raw = pxn[k]; if (!inb) raw = (u32x4){0u, 0u, 0u, 0u};
              u[0] += cw[k][0] * bflo(raw.x); u[1] += cw[k][1] * bfhi(raw.x); u[2] += cw[k][2] * bflo(raw.y); u[3] += cw[k][3] * bfhi(raw.y);
              u[4] += cw[k][4] * bflo(raw.z); u[5] += cw[k][5] * bfhi(raw.z); u[6] += cw[k][6] * bflo(raw.w); u[7] += cw[k][7] * bfhi(raw.w); }
          u32x4 pb; pb.x = pk2(u[0], u[1]); pb.y = pk2(u[2], u[3]); pb.z = pk2(u[4], u[5]); pb.w = pk2(u[6], u[7]);
          *(LAS u32x4*)(lds + L_UB + ct * 144 + c8 * 16) = pb;
          *(LAS f32x4*)(lds + L_UF + (ct * 68 + 8 * c8) * 4) = (f32x4){u[0], u[1], u[2], u[3]};
          *(LAS f32x4*)(lds + L_UF + (ct * 68 + 8 * c8 + 4) * 4) = (f32x4){u[4], u[5], u[6], u[7]}; }
        const u32x4 graw = pgn; const float hin_cur = hinn;
        if (it + 1 < it_end) issue(it + 1);
        LDS_BARRIER();
        { LAS unsigned char* Aa = lds + L_AB + gdir * 2 * L_ARR; LAS unsigned char* Bb = Aa + L_ARR;
#pragma unroll
          for (int tb = 0; tb < 4; ++tb) { const int t = 16 * tb + fr;
              const bf16x8 u0 = LDS_FRAG(lds + L_UB + t * 144 + fq * 16), u1 = LDS_FRAG(lds + L_UB + t * 144 + fq * 16 + 64);
              f32x4 ga = mfma16(wa0, u0, (f32x4){0.f, 0.f, 0.f, 0.f}); ga = mfma16(wa1, u1, ga);
              f32x4 gx = mfma16(wx0, u0, (f32x4){0.f, 0.f, 0.f, 0.f}); gx = mfma16(wx1, u1, gx);
              const f32x4 uf = *(const LAS f32x4*)(lds + L_UF + (t * 68 + e0) * 4);
              f32x4 av, bv;
#pragma unroll
              for (int j = 0; j < 4; ++j) {
                  const float d1 = 1.0f + __builtin_amdgcn_exp2f(fminf(ga[j] + ba[j], 30.0f)), d2 = 1.0f + __builtin_amdgcn_exp2f(fminf(gx[j] + bx[j], 30.0f));
                  const float rc = __builtin_amdgcn_rcpf(d1 * d2), rg = rc * d2, ig = rc * d1;
                  const float aa = __builtin_amdgcn_exp2f(rg * sp[j]);
                  av[j] = aa; bv[j] = __builtin_amdgcn_sqrtf(fmaf(-aa, aa, 1.0f)) * (ig * uf[j]); }
              *(LAS f32x4*)(Aa + (t * 68 + e0) * 4) = av; *(LAS f32x4*)(Bb + (t * 68 + e0) * 4) = bv; } }
        LDS_BARRIER();
        { const int dir = wave >> 2, seg = wave & 3, e = lane;
          const LAS float* ap = (const LAS float*)(lds + L_AB + dir * 2 * L_ARR) + (16 * seg) * 68 + e;
          LAS float* bp = (LAS float*)(lds + L_AB + dir * 2 * L_ARR + L_ARR) + (16 * seg) * 68 + e;
          float av[16], bv[16];
#pragma unroll
          for (int i = 0; i < 16; ++i) { av[i] = ap[i * 68]; bv[i] = bp[i * 68]; }
          float Pm = 1.f, H = 0.f;
          if (dir == 0) {
#pragma unroll
              for (int i = 0; i < 16; ++i) { H = av[i] * H + bv[i]; Pm *= av[i]; } }
          else {
#pragma unroll
              for (int i = 15; i >= 0; --i) { H = av[i] * H + bv[i]; Pm *= av[i]; } }
          typedef float f32x2v __attribute__((ext_vector_type(2)));
          LAS f32x2v* sg = (LAS f32x2v*)(lds + L_SEG);
          sg[(dir * 4 + seg) * 64 + e] = (f32x2v){Pm, H};
          LDS_BARRIER();
          if (PASS == 1) {
              if (seg == 0) { float Pc = 1.f, Hc = 0.f;
#pragma unroll
                  for (int s = 0; s < 4; ++s) { const f32x2v ph = sg[(dir * 4 + (dir == 0 ? s : 3 - s)) * 64 + e]; Hc = ph.x * Hc + ph.y; Pc *= ph.x; }
                  *(float2*)(q.car + 2 * (size_t)(((b * 64 + r) * 2 + dir) * DLRU + 64 * h + e)) = make_float2(Pc, Hc); }
          } else {
              float Hc = hin_cur;
#pragma unroll
              for (int s = 0; s < 3; ++s) { const int sidx = (dir == 0) ? s : 3 - s; const bool use = (dir == 0) ? (s < seg) : (sidx > seg);
                  const f32x2v ph = sg[(dir * 4 + sidx) * 64 + e]; if (use) Hc = ph.x * Hc + ph.y; }
              if (dir == 0) {
#pragma unroll
                  for (int i = 0; i < 16; ++i) { Hc = av[i] * Hc + bv[i]; bp[i * 68] = Hc; } }
              else {
#pragma unroll
                  for (int i = 15; i >= 0; --i) { Hc = av[i] * Hc + bv[i]; bp[i * 68] = Hc; } }
          } }
        if (PASS == 2) {
            LDS_BARRIER();
            const size_t tok = (size_t)(t0 + ct);
            const LAS float* B0 = (const LAS float*)(lds + L_AB + L_ARR) + ct * 68 + 8 * c8; const LAS float* B1 = (const LAS float*)(lds + L_AB + 3 * L_ARR) + ct * 68 + 8 * c8;
            const f32x4 h0 = *(const LAS f32x4*)B0 + *(const LAS f32x4*)B1, h1 = *(const LAS f32x4*)(B0 + 4) + *(const LAS f32x4*)(B1 + 4);
            float gv[8] = {bflo(graw.x), bfhi(graw.x), bflo(graw.y), bfhi(graw.y), bflo(graw.z), bfhi(graw.z), bflo(graw.w), bfhi(graw.w)};
            float hs[8] = {h0[0], h0[1], h0[2], h0[3], h1[0], h1[1], h1[2], h1[3]}, y[8];
#pragma unroll
            for (int j = 0; j < 8; ++j) { const float x = gv[j], z = 0.7978845608028654f * (x + 0.044715f * x * x * x); y[j] = x * sigmoidf_(2.0f * z) * hs[j]; }
            u32x4 o; o.x = pk2(y[0], y[1]); o.y = pk2(y[2], y[3]); o.z = pk2(y[4], y[5]); o.w = pk2(y[6], y[7]);
            *(u32x4*)(q.Y + tok * DM + 256 + 64 * h + 8 * c8) = o;
        }
        LDS_BARRIER();
    }
}
__device__ __forceinline__ void lru_carry_scan(const float* car, float* hin, int tid) {
    const int gt = blockIdx.x * NTHR + tid;
    if (gt < NBATCH * 2 * DLRU) { const int ch = gt % DLRU, dir = (gt / DLRU) & 1, b = gt / (2 * DLRU);
        typedef float f32x2c __attribute__((ext_vector_type(2)));
        float H = 0.f;
#pragma unroll 1
        for (int rb = 0; rb < 4; ++rb) {
            f32x2c pe[16];
#pragma unroll
            for (int k = 0; k < 16; ++k) { const int r = (dir == 0) ? (16 * rb + k) : (63 - 16 * rb - k);
                pe[k] = *(const f32x2c*)(car + 2 * (size_t)(((b * 64 + r) * 2 + dir) * DLRU + ch)); }
            __builtin_amdgcn_sched_barrier(0);
#pragma unroll
            for (int k = 0; k < 16; ++k) { const int r = (dir == 0) ? (16 * rb + k) : (63 - 16 * rb - k);
                hin[((b * 64 + r) * 2 + dir) * DLRU + ch] = H; H = pe[k].x * H + pe[k].y; }
            __builtin_amdgcn_sched_barrier(0); } }
}

constexpr int N_K = 0, N_V = 73728, N_VS = 584, N_RPB = 148480;
constexpr float LOG2E = 1.4426950408889634f;
__device__ __forceinline__ void na_store_row(LAS unsigned char* lds, int slot, int col, int ch, u32x4 kraw, u32x4 vraw) {
    const int key = slot * 64 + col;
    *(LAS u32x4*)(lds + N_K + key * 128 + ((ch ^ (key & 7)) << 4)) = kraw;
    LAS bf16* vt = (LAS bf16*)(lds + N_V) + (8 * ch) * N_VS + key;
    vt[0 * N_VS] = (bf16)(vraw.x & 0xffffu); vt[1 * N_VS] = (bf16)(vraw.x >> 16); vt[2 * N_VS] = (bf16)(vraw.y & 0xffffu); vt[3 * N_VS] = (bf16)(vraw.y >> 16);
    vt[4 * N_VS] = (bf16)(vraw.z & 0xffffu); vt[5 * N_VS] = (bf16)(vraw.z >> 16); vt[6 * N_VS] = (bf16)(vraw.w & 0xffffu); vt[7 * N_VS] = (bf16)(vraw.w >> 16);
}
__device__ __forceinline__ void na_phase(LAS unsigned char* lds, const bf16* P, const float* rpb, bf16* Y, int tid, int wave, int lane, int G) {
    const int fr = lane & 15, fq = lane >> 4;
    const int rsel = wave >> 2, qb = wave & 3;
    const int kstart = min(max(16 * qb - 8, 0), 32);
    const int c = 16 * qb + fr, cs = min(max(c - 8, 0), 48);
    float madd[2][4]; int dcc[2][4];
#pragma unroll
    for (int t = 0; t < 2; ++t)
#pragma unroll
        for (int j = 0; j < 4; ++j) { const int kc = kstart + 16 * t + 4 * fq + j; madd[t][j] = (kc >= cs && kc < cs + 16) ? 0.0f : -1e30f; dcc[t][j] = min(max(kc - c + 15, 0), 30); }
    const int lcol = tid >> 3, lch = tid & 7;
    const LAS float* rl = (const LAS float*)(lds + N_RPB);
    const int per_blk = (NBATCH * 6 * 32 + G - 1) / G;
    int pp = blockIdx.x * per_blk; const int pp_end = min(pp + per_blk, NBATCH * 6 * 32);
    int prev_bh = -1; bf16x8 qn0, qn1;
    {
#pragma unroll 1
        for (; pp < pp_end; ++pp) {
            const int bh = pp >> 5, rp = pp & 31, h = bh % 6, b = bh / 6;
            const bf16* Pb = P + (size_t)b * SEQ * DINP + 64 * h;
            const int r0 = 2 * rp, band_lo = min(max(r0 - 4, 0), 56);
            if (bh != prev_bh) { prev_bh = bh;
                LDS_BARRIER();
                { u32x4 kk[9], vv[9];
#pragma unroll
                  for (int i = 0; i < 9; ++i) { const bf16* src = Pb + (size_t)(min(band_lo + i, 63) * 64 + lcol) * DINP + 8 * lch;
                      kk[i] = *(const u32x4*)(src + 1408); vv[i] = *(const u32x4*)(src + 1792); }
                  __builtin_amdgcn_sched_barrier(0);
#pragma unroll
                  for (int i = 0; i < 9; ++i) if (band_lo + i <= 63) na_store_row(lds, (band_lo + i) % 9, lcol, lch, kk[i], vv[i]);
                  if (tid < 465) ((LAS float*)(lds + N_RPB))[tid] = rpb[h * 465 + tid] * LOG2E; }
                { const bf16* qp = Pb + (size_t)((r0 + rsel) * 64 + c) * DINP + 1024 + 8 * fq; qn0 = *(const bf16x8*)qp; qn1 = *(const bf16x8*)(qp + 32); }
                LDS_BARRIER(); }
            const bool more = (pp + 1 < pp_end) && (rp < 31); const int bln = min(max(r0 - 2, 0), 56); const bool shift = more && (bln != band_lo);
            const bf16x8 q0 = qn0, q1 = qn1;
            u32x4 kpre[2], vpre[2];
            if (more) { const bf16* qp = Pb + (size_t)((r0 + 2 + rsel) * 64 + c) * DINP + 1024 + 8 * fq; qn0 = *(const bf16x8*)qp; qn1 = *(const bf16x8*)(qp + 32); }
#pragma unroll
            for (int j = 0; j < 2; ++j) { const int grow = min(band_lo + 9 + j, 63); const bf16* src = Pb + (size_t)(grow * 64 + lcol) * DINP + 8 * lch;
                if (shift) { kpre[j] = *(const u32x4*)(src + 1408); vpre[j] = *(const u32x4*)(src + 1792); } }
            { const int r = r0 + rsel, rs = min(max(r - 4, 0), 56);
              const int slot0 = rs % 9;
              f32x4 s[8][2]; float mx = -1e30f;
#pragma unroll
              for (int g2 = 0; g2 < 4; ++g2) {
                  bf16x8 kf[2][2][2]; float bw[2][2][4];
#pragma unroll
                  for (int u = 0; u < 2; ++u) { const int kr = 2 * g2 + u; int slot = slot0 + kr; slot = (slot >= 9) ? slot - 9 : slot; const int dr31 = (rs + kr - r + 7) * 31;
#pragma unroll
                      for (int t = 0; t < 2; ++t) { const int key = slot * 64 + kstart + 16 * t + fr; const LAS unsigned char* ka = lds + N_K + key * 128;
                          kf[u][t][0] = LDS_FRAG(ka + ((fq ^ (key & 7)) << 4)); kf[u][t][1] = LDS_FRAG(ka + (((4 + fq) ^ (key & 7)) << 4));
#pragma unroll
                          for (int j = 0; j < 4; ++j) bw[u][t][j] = rl[dr31 + dcc[t][j]]; } }
                  __builtin_amdgcn_sched_barrier(0);
#pragma unroll
                  for (int u = 0; u < 2; ++u)
#pragma unroll
                      for (int t = 0; t < 2; ++t) { f32x4 acc = mfma16(kf[u][t][0], q0, (f32x4){0.f, 0.f, 0.f, 0.f}); acc = mfma16(kf[u][t][1], q1, acc);
#pragma unroll
                          for (int j = 0; j < 4; ++j) { const float v = (acc[j] + bw[u][t][j]) + madd[t][j]; acc[j] = v; mx = fmaxf(mx, v); }
                          s[2 * g2 + u][t] = acc; }
                  __builtin_amdgcn_sched_barrier(0); }
              mx = fmaxf(mx, __shfl_xor(mx, 16)); mx = fmaxf(mx, __shfl_xor(mx, 32));
              float sum = 0.f;
#pragma unroll
              for (int kr = 0; kr < 8; ++kr)
#pragma unroll
                  for (int t = 0; t < 2; ++t)
#pragma unroll
                      for (int j = 0; j < 4; ++j) { const float p = __builtin_amdgcn_exp2f(s[kr][t][j] - mx); s[kr][t][j] = p; sum += p; }
              sum += __shfl_xor(sum, 16); sum += __shfl_xor(sum, 32);
              f32x4 O[4];
#pragma unroll
              for (int db = 0; db < 4; ++db) O[db] = (f32x4){0.f, 0.f, 0.f, 0.f};
              const LAS bf16* vbase = (const LAS bf16*)(lds + N_V) + fr * N_VS + kstart + 4 * fq;
              u32x2 va[2][4], vb[2][4];
#pragma unroll
              for (int db = 0; db < 4; ++db) { const LAS bf16* vp = vbase + 16 * db * N_VS + slot0 * 64; va[0][db] = *(const LAS u32x2*)vp; vb[0][db] = *(const LAS u32x2*)(vp + 16); }
#pragma unroll
              for (int kr = 0; kr < 8; ++kr) {
                  if (kr < 7) { int slot = slot0 + kr + 1; slot = (slot >= 9) ? slot - 9 : slot;
#pragma unroll
                      for (int db = 0; db < 4; ++db) { const LAS bf16* vp = vbase + 16 * db * N_VS + slot * 64; va[(kr + 1) & 1][db] = *(const LAS u32x2*)vp; vb[(kr + 1) & 1][db] = *(const LAS u32x2*)(vp + 16); } }
                  __builtin_amdgcn_sched_barrier(0);
                  const u32x2 pa = pk4(s[kr][0]), pb = pk4(s[kr][1]); u32x4 pw; pw.x = pa.x; pw.y = pa.y; pw.z = pb.x; pw.w = pb.y;
                  const bf16x8 pf = __builtin_bit_cast(bf16x8, pw);
#pragma unroll
                  for (int db = 0; db < 4; ++db) { u32x4 vw; vw.x = va[kr & 1][db].x; vw.y = va[kr & 1][db].y; vw.z = vb[kr & 1][db].x; vw.w = vb[kr & 1][db].y;
                      O[db] = mfma16(__builtin_bit_cast(bf16x8, vw), pf, O[db]); }
                  __builtin_amdgcn_sched_barrier(0); }
              const float inv = __builtin_amdgcn_rcpf(sum);
              bf16* yp = Y + (size_t)(b * SEQ + r * 64 + c) * DM + 640 + 64 * h + 4 * fq;
#pragma unroll
              for (int db = 0; db < 4; ++db) *(u32x2*)(yp + 16 * db) = pk4(O[db] * inv); }
            if (more) {
                LDS_BARRIER();
                if (shift) {
#pragma unroll
                    for (int j = 0; j < 2; ++j) { const int grow = band_lo + 9 + j; if (grow <= 63) na_store_row(lds, grow % 9, lcol, lch, kpre[j], vpre[j]); } }
                LDS_BARRIER();
            }
        }
    }
    LDS_BARRIER();
}

typedef __attribute__((address_space(1))) unsigned gu32;
#define RLX_AGENT __ATOMIC_RELAXED, __HIP_MEMORY_SCOPE_AGENT
#define XB_TMO      128
#define XB_XCNT(j)  (256  + 64 * (j))
#define XB_XSUB(j)  (1280 + 64 * (j))
#define XB_XGEN(j)  (2304 + 64 * (j))
#define XB_TOP      3328
#define XB_TOPGEN   3392
#define XCD_BAR_WORDS 3456
#define XB_SPIN_CAP (1u << 18)

__device__ __forceinline__ unsigned xb_ld(unsigned* p)              { return __hip_atomic_load(p, __ATOMIC_RELAXED, __HIP_MEMORY_SCOPE_AGENT); }
__device__ __forceinline__ unsigned xb_add(unsigned* p, unsigned v) { return __hip_atomic_fetch_add(p, v, __ATOMIC_RELAXED, __HIP_MEMORY_SCOPE_AGENT); }
__device__ __forceinline__ unsigned xb_xcc_id() { return (unsigned)__builtin_amdgcn_s_getreg((3 << 11) | 20) & 0xFu; }
#define XB_SPIN(cond, bar) do { unsigned _sp = 0; while (cond) { __builtin_amdgcn_s_sleep(1); \
    if ((++_sp & 255u) == 0u) { if (xb_ld(&(bar)[XB_TMO])) break; if (_sp > XB_SPIN_CAP) { atomicAdd(&(bar)[XB_TMO], 1u); break; } } } } while (0)

struct XcdBarrier {
    unsigned* bar; unsigned x;
    volatile LAS unsigned* st;
};

__device__ __forceinline__ XcdBarrier xcd_barrier_post(unsigned* bar, volatile LAS unsigned* st) {
    XcdBarrier b; b.bar = bar; b.x = xb_xcc_id(); b.st = st;
    if (threadIdx.x == 0) (void)xb_add(&bar[XB_XCNT(b.x)], 1u);
    return b;
}
__device__ __forceinline__ void xcd_barrier_complete(unsigned* bar, unsigned x, unsigned& nloc, unsigned& nx) {
    const unsigned G = gridDim.x * gridDim.y * gridDim.z;
    unsigned sum, cnt, mine, sp = 0u;
    for (;;) {
        sum = 0u; cnt = 0u; mine = 0u;
#pragma unroll
        for (unsigned j = 0; j < 16; ++j) { const unsigned c = xb_ld(&bar[XB_XCNT(j)]); sum += c; cnt += (c > 0u) ? 1u : 0u; mine = (j == x) ? c : mine; }
        if (sum == G) break;
        __builtin_amdgcn_s_sleep(1);
        if ((++sp & 255u) == 0u) { if (xb_ld(&bar[XB_TMO])) break; if (sp > XB_SPIN_CAP) { atomicAdd(&bar[XB_TMO], 1u); break; } }
    }
    nloc = mine > 0u ? mine : 1u; nx = cnt > 0u ? cnt : 1u;
}

__device__ __forceinline__ void xcd_barrier(const XcdBarrier& b) {
    asm volatile("s_waitcnt vmcnt(0)" ::: "memory");
    __syncthreads();
    if (threadIdx.x == 0) {
        unsigned* bar = b.bar;
        __builtin_amdgcn_s_waitcnt(0);
        unsigned nloc = b.st[0], nx = b.st[1];
        if (nloc == 0u) { xcd_barrier_complete(bar, b.x, nloc, nx); b.st[0] = nloc; b.st[1] = nx; }
        const unsigned old = xb_add(&bar[XB_XSUB(b.x)], 1u);
        const unsigned gen = old / nloc;
        if (old + 1u == (gen + 1u) * nloc) {
            __builtin_amdgcn_fence(__ATOMIC_RELEASE, "agent");
            asm volatile("s_waitcnt vmcnt(0)" ::: "memory");
            const unsigned og = xb_add(&bar[XB_TOP], 1u);
            const unsigned tg = og / nx;
            if (og + 1u == (tg + 1u) * nx) xb_add(&bar[XB_TOPGEN], 1u);
            else XB_SPIN(xb_ld(&bar[XB_TOPGEN]) == tg, bar);
            __builtin_amdgcn_fence(__ATOMIC_ACQUIRE, "agent");
            xb_add(&bar[XB_XGEN(b.x)], 1u);
            asm volatile("s_waitcnt vmcnt(0)" ::: "memory");
        } else {
            XB_SPIN(xb_ld(&bar[XB_XGEN(b.x)]) == gen, bar);
            __builtin_amdgcn_fence(__ATOMIC_ACQUIRE, "agent");
            asm volatile("s_waitcnt vmcnt(0)" ::: "memory");
        }
    }
    __syncthreads();
}


#ifndef REP_NA
#define REP_NA 1
#endif
#ifndef REP_F
#define REP_F 1
#endif
#ifndef REP_L
#define REP_L 1
#endif
#ifndef REP_N
#define REP_N 1
#endif
#ifndef REP_G1
#define REP_G1 1
#endif
#ifndef REP_G3
#define REP_G3 1
#endif
#ifndef REP_S
#define REP_S 1
#endif
__global__ void __launch_bounds__(NTHR, 2) fwd_megakernel(Args a) {
    extern __shared__ __attribute__((aligned(16))) unsigned char lds_raw[];
    LAS unsigned char* lds = (LAS unsigned char*)lds_raw;
    cg::grid_group grid = cg::this_grid();
    const int G = gridDim.x;
#define GRID_SYNC_CG() do { asm volatile("s_waitcnt vmcnt(0) lgkmcnt(0)" ::: "memory"); grid.sync(); __builtin_amdgcn_fence(__ATOMIC_ACQUIRE, "agent"); asm volatile("s_waitcnt vmcnt(0)" ::: "memory"); } while (0)
#define GRID_SYNC() do { for (int rs_ = 0; rs_ < REP_S; ++rs_) xcd_barrier(xbar); } while (0)
#define FRESH() int t_ = threadIdx.x; asm volatile("" : "+v"(t_)); const int tid = t_, lane = tid & 63, wave = __builtin_amdgcn_readfirstlane(tid >> 6); (void)lane; (void)wave;
    unsigned char* ws = a.ws;
    bf16* const Hb = (bf16*)(ws + WS_H); bf16* const Pb = (bf16*)(ws + WS_P); bf16* const Yb = (bf16*)(ws + WS_Y); bf16* const HIDb = (bf16*)(ws + WS_HID);
    bf16* const Z2 = (bf16*)(ws + WS_H);
    float* const out = a.out;
    volatile LAS unsigned* xst = (volatile LAS unsigned*)(lds + LDS_BYTES - 16);
    if (threadIdx.x < 4) xst[threadIdx.x] = 0u;
    __syncthreads();
    const XcdBarrier xbar = xcd_barrier_post((unsigned*)(ws + WS_BAR), xst);

#ifndef REP_PA
#define REP_PA 1
#endif
    for (int rep = 0; rep < REP_PA; ++rep) { FRESH(); phase_prologue_a(a, lds, tid, wave, lane, G); __syncthreads(); }
    GRID_SYNC_CG();
    { FRESH(); phase_prologue_b(a, tid, G); }
    GRID_SYNC();

    { FRESH(); phase_xt0(a.in[0], a.in[4], (const float*)(ws + WS_MOD), 1024, Hb, (float*)(ws + WS_SS), wave, lane, G); phase_bias(ws, wave, lane, G); }
    GRID_SYNC();
    float* const SSb = (float*)(ws + WS_SS);
    bf16* const XBb = (bf16*)(ws + WS_XB);
    for (int l = 0; l < DEPTH; ++l) {
        const float* modl = (const float*)(ws + WS_MOD) + (size_t)l * NBATCH * 6144;
        for (int rep = 0; rep < REP_G1; ++rep) { pg8::Gemm g{Hb, (const bf16*)(ws + WS_WIN) + (size_t)l * DINP * DM, T, DINP, DM}; pg8::StaticOrder S; S.init(T, DINP, G, (int)blockIdx.x);
          pg8::EpiP E{Pb, DINP, SSb, (const float*)(ws + WS_BIN) + (size_t)l * NBATCH * DINP, DINP};
          pg8::gemm_phase<pg8::EpiP, pg8::StaticOrder, true, true>(lds, g, S, E); }
        GRID_SYNC();
        LruPtrs lp{Pb, (const bf16*)(ws + WS_WLRU), a.in[8], a.in[9], a.in[11], a.in[13], a.in[14], (float*)(ws + WS_CAR), (const float*)(ws + WS_HIN), Yb, nullptr};
        for (int rep = 0; rep < REP_L; ++rep) { FRESH(); lru_phase<1>(lds, lp, l, tid, wave, lane, G); }
        GRID_SYNC();
        { FRESH(); lru_carry_scan((const float*)(ws + WS_CAR), (float*)(ws + WS_HIN), tid); }
        for (int rep = 0; rep < REP_F; ++rep) { FRESH(); build_dft_tables(lds, tid); __syncthreads();
          { constexpr int NF = NBATCH * 4 * 64; const int perf = (NF + G - 1) / G; int it = blockIdx.x * perf; const int ite = min(it + perf, NF);
            u32x4 cur = fourier1_load(Pb, it < NF ? it : 0, tid);
            for (; it < ite; ++it) { u32x4 nxt = cur; if (it + 1 < ite) nxt = fourier1_load(Pb, it + 1, tid);
                fourier1_item(lds, cur, Z2, it, tid, wave, lane, nullptr); cur = nxt; } }
          __syncthreads(); }
        for (int rep = 0; rep < REP_NA; ++rep) { FRESH(); na_phase(lds, Pb, a.in[15] + (size_t)l * 6 * 465, Yb, tid, wave, lane, G); }
        GRID_SYNC();
        for (int rep = 0; rep < REP_F; ++rep) { FRESH(); build_dft_tables(lds, tid); __syncthreads();
          { const bf16* WFl = (const bf16*)(ws + WS_WF) + (size_t)l * 4 * 4096; constexpr int NF = NBATCH * 4 * 64; const int perf = (NF + G - 1) / G; int it = blockIdx.x * perf; const int ite = min(it + perf, NF);
            F2Pre cur = fourier2_load(Z2, WFl, it < NF ? it : 0, tid);
            for (; it < ite; ++it) { F2Pre nxt = cur; if (it + 1 < ite) nxt = fourier2_load(Z2, WFl, it + 1, tid);
                fourier2_item(lds, cur, Yb, it, tid, wave, lane, nullptr); cur = nxt; } }
          __syncthreads(); }
        for (int rep = 0; rep < REP_L; ++rep) { FRESH(); lru_phase<2>(lds, lp, l, tid, wave, lane, G); }
        GRID_SYNC();
        { pg8::Gemm g{Yb, (const bf16*)(ws + WS_WOUT) + (size_t)l * DM * DM, T, DM, DM}; pg8::StaticOrder S; S.init(T, DM, G, (int)blockIdx.x);
          pg8::EpiRes E{l == 0 ? a.in[0] : nullptr, l == 0 ? nullptr : XBb, XBb, modl + 2048, a.in[5] + l * DM, modl + 4096, Hb, SSb};
          pg8::gemm_phase<pg8::EpiRes, pg8::StaticOrder, true, true>(lds, g, S, E); }
        GRID_SYNC();
        for (int rep = 0; rep < REP_G3; ++rep) { pg8::Gemm g{Hb, (const bf16*)(ws + WS_WGU) + (size_t)l * 5632 * DM, T, 5632, DM}; pg8::StaticOrder S; S.init(T, 5632, G, (int)blockIdx.x);
          pg8::EpiSwiGLU E{HIDb, SSb, (const float*)(ws + WS_BGU) + (size_t)l * NBATCH * 5632};
          pg8::gemm_phase<pg8::EpiSwiGLU, pg8::StaticOrder, true, true>(lds, g, S, E); }
        GRID_SYNC();
        { pg8::Gemm g{HIDb, (const bf16*)(ws + WS_WDN) + (size_t)l * DM * DFF, T, DM, DFF}; pg8::StaticOrder S; S.init(T, DM, G, (int)blockIdx.x);
          const bool more = (l + 1 < DEPTH);
          pg8::EpiRes E{nullptr, XBb, XBb, modl + 5120, more ? a.in[4] + (l + 1) * DM : nullptr, more ? modl + NBATCH * 6144 + 1024 : modl, Hb, SSb};
          pg8::gemm_phase<pg8::EpiRes, pg8::StaticOrder, true, true>(lds, g, S, E); }
        GRID_SYNC();
    }
    { FRESH(); phase_final_norm(XBb, out, a.in[20], wave, lane, G); }
}

extern "C" void kernel_launch(void* const* d_in, const int* in_sizes, int n_in, void* d_out, int out_size, void* d_ws, size_t ws_size, hipStream_t stream) {
    static int grid_blocks = 0;
    if (grid_blocks == 0) {
        if (n_in != 21 || out_size != T * DM || ws_size < WS_END) { fprintf(stderr, "kernel_launch: unexpected problem (n_in %d, out %d, ws %zu)\n", n_in, out_size, ws_size); grid_blocks = -1; return; }
        int dev = 0, cus = 0, per_cu = 0;
        hipGetDevice(&dev);
        hipDeviceGetAttribute(&cus, hipDeviceAttributeMultiprocessorCount, dev);
        if (hipFuncSetAttribute((const void*)fwd_megakernel, hipFuncAttributeMaxDynamicSharedMemorySize, LDS_BYTES) != hipSuccess) { fprintf(stderr, "kernel_launch: hipFuncSetAttribute failed\n"); grid_blocks = -1; return; }
        if (hipOccupancyMaxActiveBlocksPerMultiprocessor(&per_cu, (const void*)fwd_megakernel, NTHR, LDS_BYTES) != hipSuccess || per_cu < 1) { fprintf(stderr, "kernel_launch: occupancy query failed (%d)\n", per_cu); per_cu = 1; (void)hipGetLastError(); }
        grid_blocks = cus * per_cu;
    }
    if (grid_blocks < 0) return;
    Args a{};
    for (int i = 0; i < 21; ++i) a.in[i] = (const float*)d_in[i];
    a.out = (float*)d_out; a.ws = (unsigned char*)d_ws;
    if (hipMemsetAsync((unsigned char*)d_ws + WS_BAR, 0, XCD_BAR_WORDS * 4, stream) != hipSuccess) { fprintf(stderr, "kernel_launch: memset of the barrier words failed\n"); return; }
    void* args[] = {&a};
    hipError_t e = hipLaunchCooperativeKernel((const void*)fwd_megakernel, dim3(grid_blocks), dim3(NTHR), args, LDS_BYTES, stream);
    if (e != hipSuccess) fprintf(stderr, "cooperative launch failed: %s (grid %d)\n", hipGetErrorString(e), grid_blocks);
}
```
